# Optimizing an MI355X kernel written in HIP

```python
import math
import jax, jax.numpy as jnp
from jax import lax
import numpy as np

D_MODEL = 2048
BATCH = 4
SEQ = 4096
DEPTH = 4

N_EVEN = (DEPTH + 1) // 2
N_ODD = DEPTH // 2
HEAD_DIM = 128
FOX_HEADS = (D_MODEL // 2) // HEAD_DIM
RET_HEADS = (D_MODEL // 2) // HEAD_DIM
FOX_WIDTH = FOX_HEADS * HEAD_DIM
RET_WIDTH = RET_HEADS * HEAD_DIM
Q_BLOCK = 128
RET_CHUNK = 128
S5_WIDTH = D_MODEL // 2
S5_GROUP = 16
S5_GROUPS = S5_WIDTH // S5_GROUP
S5_STATE = 64
CONV_WIDTH = D_MODEL // 2
CONV_K = 3
MEM_LEN = 256
XA_HEADS = 4
XA_HEAD_DIM = 128
XA_WIDTH = XA_HEADS * XA_HEAD_DIM
D_FF = 4 * D_MODEL
EVEN_IN = 3 * FOX_WIDTH + FOX_HEADS + 4 * RET_WIDTH
ODD_IN = S5_WIDTH + 3 * CONV_WIDTH
MIX_OUT = FOX_WIDTH + RET_WIDTH
EPS = 1e-6
ROPE_BASE = 10000.0

kernel_name = 'hybrid_fox_retnet_s5_shortconv_trunk'

F32 = jnp.float32


def rmsnorm(x, g):
    xf = x.astype(F32)
    y = xf * lax.rsqrt(jnp.mean(xf * xf, axis=-1, keepdims=True) + EPS)
    return (y * g.astype(F32)).astype(x.dtype)


def to_heads(t, n_heads):
    b, l, _ = t.shape
    return t.reshape(b, l, n_heads, -1).transpose(0, 2, 1, 3)


def fox_attention(q, k, v, f_logit):
    b, h, l, d = q.shape
    nq = l // Q_BLOCK
    c = jnp.cumsum(jax.nn.log_sigmoid(f_logit.astype(F32)), axis=1).transpose(0, 2, 1)
    qb = q.reshape(b, h, nq, Q_BLOCK, d).transpose(2, 0, 1, 3, 4)
    cb = c.reshape(b, h, nq, Q_BLOCK).transpose(2, 0, 1, 3)
    kpos = jnp.arange(l)
    scale = d ** -0.5

    def block(args):
        qi, ci, i = args
        s = jnp.einsum('bhqd,bhkd->bhqk', qi, k, preferred_element_type=F32) * scale
        s = s + ci[..., None] - c[:, :, None, :]
        qpos = i * Q_BLOCK + jnp.arange(Q_BLOCK)
        s = jnp.where(qpos[:, None] >= kpos[None, :], s, -jnp.inf)
        p = jax.nn.softmax(s, axis=-1)
        return jnp.einsum('bhqk,bhkd->bhqd', p.astype(v.dtype), v)

    o = lax.map(block, (qb, cb, jnp.arange(nq)))
    return o.transpose(1, 0, 3, 2, 4).reshape(b, l, h * d)


def rotary(t):
    d = t.shape[-1]
    l = t.shape[2]
    half = d // 2
    inv = ROPE_BASE ** (-jnp.arange(half, dtype=F32) / half)
    ang = jnp.arange(l, dtype=F32)[:, None] * inv[None, :]
    cos, sin = jnp.cos(ang), jnp.sin(ang)
    t1 = t[..., :half].astype(F32)
    t2 = t[..., half:].astype(F32)
    return jnp.concatenate([t1 * cos - t2 * sin, t1 * sin + t2 * cos], axis=-1).astype(t.dtype)


def retention(q, k, v):
    b, h, l, d = q.shape
    cs = RET_CHUNK
    n = l // cs
    q = rotary(q)
    k = rotary(k) * (d ** -0.5)
    log_g = jnp.log1p(-jnp.exp2(-5.0 - jnp.arange(h, dtype=F32)))
    pos = jnp.arange(cs, dtype=F32)
    diff = pos[:, None] - pos[None, :]
    dmask = jnp.where(diff >= 0, jnp.exp(log_g[:, None, None] * jnp.maximum(diff, 0.0)), 0.0)
    zeta = jnp.exp(log_g[:, None] * (cs - 1 - pos)[None, :])
    xi = jnp.exp(log_g[:, None] * (pos + 1)[None, :])
    g_chunk = jnp.exp(log_g * cs)
    qc = q.reshape(b, h, n, cs, d)
    kc = k.reshape(b, h, n, cs, d)
    vc = v.reshape(b, h, n, cs, d)
    s = jnp.einsum('bhnid,bhnjd->bhnij', qc, kc, preferred_element_type=F32) * dmask[None, :, None]
    o_intra = jnp.einsum('bhnij,bhnje->bhnie', s, vc.astype(F32))
    kv = jnp.einsum('bhnjd,hj,bhnje->nbhde', kc.astype(F32), zeta, vc.astype(F32))

    def step(r, kv_n):
        return g_chunk[None, :, None, None] * r + kv_n, r

    _, r_prev = lax.scan(step, jnp.zeros_like(kv[0]), kv)
    o_cross = jnp.einsum('bhnid,nbhde->bhnie', qc.astype(F32), r_prev) * xi[None, :, None, :, None]
    o = (o_intra + o_cross).reshape(b, h, l, d)
    mu = jnp.mean(o, axis=-1, keepdims=True)
    var = jnp.mean(jnp.square(o - mu), axis=-1, keepdims=True)
    o = (o - mu) * lax.rsqrt(var + EPS)
    return o.transpose(0, 2, 1, 3).reshape(b, l, h * d)


def s5_mixer(u, a_re, a_im, b_re, b_im, c_re, c_im, d_skip, log_step, w_glu):
    bsz, l, _ = u.shape
    uf = u.astype(F32).reshape(bsz, l, S5_GROUPS, S5_GROUP)
    lam = lax.complex(jnp.minimum(a_re.astype(F32), -1e-4), a_im.astype(F32))
    step = jnp.exp(log_step.astype(F32))
    a_bar = jnp.exp(lam * step)
    b_bar = ((a_bar - 1.0) / lam)[..., None] * lax.complex(b_re.astype(F32), b_im.astype(F32))
    bu = jnp.einsum('blgc,gpc->blgp', uf.astype(jnp.complex64), b_bar)
    a_seq = jnp.broadcast_to(a_bar, (l,) + a_bar.shape)

    def combine(e1, e2):
        a1, b1 = e1
        a2, b2 = e2
        return a1 * a2, a2 * b1 + b2

    states = jax.vmap(lambda bu_b: lax.associative_scan(combine, (a_seq, bu_b), axis=0)[1])(bu)
    c_mat = lax.complex(c_re.astype(F32), c_im.astype(F32))
    y = jnp.einsum('blgp,gcp->blgc', states, c_mat).real + d_skip.astype(F32) * uf
    y = y.reshape(bsz, l, S5_WIDTH)
    g = jax.nn.gelu(y)
    return (g * jax.nn.sigmoid(g @ w_glu.astype(F32))).astype(u.dtype)


def short_conv_mixer(h, gate_b, gate_c, conv_w):
    z = gate_c * h
    rhs = conv_w[:, None, :].astype(z.dtype)
    y = lax.conv_general_dilated(z, rhs, window_strides=(1,), padding=[(CONV_K - 1, 0)],
                                 dimension_numbers=('NWC', 'WIO', 'NWC'),
                                 feature_group_count=z.shape[-1])
    return gate_b * y


def even_mixer(xn, w_in, b_forget, w_out):
    proj = xn @ w_in
    cuts = [FOX_WIDTH, 2 * FOX_WIDTH, 3 * FOX_WIDTH, 3 * FOX_WIDTH + FOX_HEADS,
            3 * FOX_WIDTH + FOX_HEADS + RET_WIDTH, 3 * FOX_WIDTH + FOX_HEADS + 2 * RET_WIDTH,
            3 * FOX_WIDTH + FOX_HEADS + 3 * RET_WIDTH]
    fq, fk, fv, ff, rq, rk, rv, rg = jnp.split(proj, cuts, axis=-1)
    fox = fox_attention(to_heads(fq, FOX_HEADS), to_heads(fk, FOX_HEADS), to_heads(fv, FOX_HEADS), ff + b_forget)
    ret = retention(to_heads(rq, RET_HEADS), to_heads(rk, RET_HEADS), to_heads(rv, RET_HEADS))
    ret = (jax.nn.silu(rg.astype(F32)) * ret).astype(xn.dtype)
    return jnp.concatenate([fox.astype(xn.dtype), ret], axis=-1) @ w_out


def odd_mixer(xn, w_in, a_re, a_im, b_re, b_im, c_re, c_im, d_skip, log_step, w_glu, conv_w, w_out):
    proj = xn @ w_in
    cuts = [S5_WIDTH, S5_WIDTH + CONV_WIDTH, S5_WIDTH + 2 * CONV_WIDTH]
    u, h, gb, gc = jnp.split(proj, cuts, axis=-1)
    ssm = s5_mixer(u, a_re, a_im, b_re, b_im, c_re, c_im, d_skip, log_step, w_glu)
    conv = short_conv_mixer(h, gb, gc, conv_w).astype(xn.dtype)
    return jnp.concatenate([ssm, conv], axis=-1) @ w_out


def cross_attention(xn, memn, wq, wkv, wo):
    b, l, _ = xn.shape
    m = memn.shape[1]
    q = (xn @ wq).reshape(b, l, XA_HEADS, XA_HEAD_DIM)
    k, v = jnp.split(memn @ wkv, 2, axis=-1)
    k = k.reshape(b, m, XA_HEADS, XA_HEAD_DIM)
    v = v.reshape(b, m, XA_HEADS, XA_HEAD_DIM)
    s = jnp.einsum('blhd,bmhd->bhlm', q, k, preferred_element_type=F32) * (XA_HEAD_DIM ** -0.5)
    p = jax.nn.softmax(s, axis=-1)
    o = jnp.einsum('bhlm,bmhd->blhd', p.astype(v.dtype), v).reshape(b, l, XA_WIDTH)
    return o @ wo


def sq_relu_mlp(xn, w1, w2):
    return jnp.square(jax.nn.relu(xn @ w1)) @ w2


def setup_inputs(seed: int = 0) -> dict:
    key = jax.random.key(seed)
    ks = jax.random.split(key, 32)

    def nrm(k, shape, scale):
        return jax.random.normal(k, shape, F32) * scale

    def gain(k, shape):
        return 1.0 + 0.05 * jax.random.normal(k, shape, F32)

    n_idx = jnp.arange(S5_STATE, dtype=F32)
    a_im0 = jnp.broadcast_to(math.pi * n_idx, (N_ODD, S5_GROUPS, S5_STATE))
    return {
        'x': nrm(ks[0], (BATCH, SEQ, D_MODEL), 1.0),
        'mem': nrm(ks[1], (BATCH, MEM_LEN, D_MODEL), 1.0),
        'norm_mix': gain(ks[2], (DEPTH, D_MODEL)),
        'norm_xattn': gain(ks[3], (DEPTH, D_MODEL)),
        'norm_mlp': gain(ks[4], (DEPTH, D_MODEL)),
        'norm_mem': gain(ks[5], (D_MODEL,)),
        'norm_final': gain(ks[6], (D_MODEL,)),
        'ab_w_in': nrm(ks[7], (N_EVEN, D_MODEL, EVEN_IN), D_MODEL ** -0.5),
        'ab_b_forget': 3.0 + 0.1 * jax.random.normal(ks[8], (N_EVEN, FOX_HEADS), F32),
        'ab_w_out': nrm(ks[9], (N_EVEN, MIX_OUT, D_MODEL), MIX_OUT ** -0.5),
        'cd_w_in': nrm(ks[10], (N_ODD, D_MODEL, ODD_IN), D_MODEL ** -0.5),
        's5_a_re': -0.5 + 0.01 * jax.random.normal(ks[11], (N_ODD, S5_GROUPS, S5_STATE), F32),
        's5_a_im': a_im0 + 0.01 * jax.random.normal(ks[12], (N_ODD, S5_GROUPS, S5_STATE), F32),
        's5_b_re': nrm(ks[13], (N_ODD, S5_GROUPS, S5_STATE, S5_GROUP), (2 * S5_GROUP) ** -0.5),
        's5_b_im': nrm(ks[14], (N_ODD, S5_GROUPS, S5_STATE, S5_GROUP), (2 * S5_GROUP) ** -0.5),
        's5_c_re': nrm(ks[15], (N_ODD, S5_GROUPS, S5_GROUP, S5_STATE), (2 * S5_STATE) ** -0.5),
        's5_c_im': nrm(ks[16], (N_ODD, S5_GROUPS, S5_GROUP, S5_STATE), (2 * S5_STATE) ** -0.5),
        's5_d': nrm(ks[17], (N_ODD, S5_GROUPS, S5_GROUP), 1.0),
        's5_log_step': jax.random.uniform(ks[18], (N_ODD, S5_GROUPS, S5_STATE), F32,
                                          minval=math.log(1e-3), maxval=math.log(1e-1)),
        's5_w_glu': nrm(ks[19], (N_ODD, S5_WIDTH, S5_WIDTH), S5_WIDTH ** -0.5),
        'conv_w': nrm(ks[20], (N_ODD, CONV_K, CONV_WIDTH), CONV_K ** -0.5),
        'cd_w_out': nrm(ks[21], (N_ODD, MIX_OUT, D_MODEL), MIX_OUT ** -0.5),
        'xa_wq': nrm(ks[22], (DEPTH, D_MODEL, XA_WIDTH), D_MODEL ** -0.5),
        'xa_wkv': nrm(ks[23], (DEPTH, D_MODEL, 2 * XA_WIDTH), D_MODEL ** -0.5),
        'xa_wo': nrm(ks[24], (DEPTH, XA_WIDTH, D_MODEL), XA_WIDTH ** -0.5),
        'mlp_w1': nrm(ks[25], (DEPTH, D_MODEL, D_FF), D_MODEL ** -0.5),
        'mlp_w2': nrm(ks[26], (DEPTH, D_FF, D_MODEL), D_FF ** -0.5),
    }


def reference(x, mem, norm_mix, norm_xattn, norm_mlp, norm_mem, norm_final,
              ab_w_in, ab_b_forget, ab_w_out, cd_w_in,
              s5_a_re, s5_a_im, s5_b_re, s5_b_im, s5_c_re, s5_c_im, s5_d, s5_log_step, s5_w_glu,
              conv_w, cd_w_out, xa_wq, xa_wkv, xa_wo, mlp_w1, mlp_w2):
    memn = rmsnorm(mem, norm_mem)
    h = x
    for layer in range(DEPTH):
        xn = rmsnorm(h, norm_mix[layer])
        if layer % 2 == 0:
            e = layer // 2
            mix = even_mixer(xn, ab_w_in[e], ab_b_forget[e], ab_w_out[e])
        else:
            o = layer // 2
            mix = odd_mixer(xn, cd_w_in[o], s5_a_re[o], s5_a_im[o], s5_b_re[o], s5_b_im[o],
                            s5_c_re[o], s5_c_im[o], s5_d[o], s5_log_step[o], s5_w_glu[o],
                            conv_w[o], cd_w_out[o])
        h = h + mix.astype(h.dtype)
        xa = cross_attention(rmsnorm(h, norm_xattn[layer]), memn, xa_wq[layer], xa_wkv[layer], xa_wo[layer])
        h = h + xa.astype(h.dtype)
        ff = sq_relu_mlp(rmsnorm(h, norm_mlp[layer]), mlp_w1[layer], mlp_w2[layer])
        h = h + ff.astype(h.dtype)
    return rmsnorm(h, norm_final)
```

```cpp
#include <hip/hip_runtime.h>
#include <hip/hip_cooperative_groups.h>
#include <cstdio>
#include <cstdint>
namespace cg = cooperative_groups;
#ifndef PG8_AUX
#define PG8_AUX 0
#endif
namespace pg8 {
#define PG8_LAS __attribute__((address_space(3)))
typedef unsigned short bf16_t;
typedef short bf16x8 __attribute__((ext_vector_type(8)));
typedef float f32x4 __attribute__((ext_vector_type(4)));
typedef unsigned u32x4 __attribute__((ext_vector_type(4)));
constexpr int BM = 256, BK = 64, HALF = 128, HTB = HALF * BK * 2  , STAGE_BYTES = 8 * HTB, NXCD = 8, WGM = 8;

__host__ __device__ __forceinline__ int lds_byte(int r, int c) { const int st = (r >> 4) * 2 + (c >> 5), rr = r & 15, cc = c & 31, ob = rr * 64 + cc * 2; return st * 1024 + (ob ^ (((ob >> 9) & 1) << 5)); }
__host__ __device__ __forceinline__ void stage_rc(int b, int& R, int& C) { const int st = b / 1024, sb = b % 1024, swz = sb ^ (((sb >> 9) & 1) << 5); R = (st >> 1) * 16 + swz / 64; C = (st & 1) * 32 + (swz % 64) / 2; }
__host__ __device__ __forceinline__ int perm32(int rho) { const int n = rho >> 4, i = rho & 15; return 8 * (i >> 2) + 4 * n + (i & 3); }

struct Unit { int pm, pn; };
struct Gemm { const bf16_t* A; const bf16_t* Bt; int M, N, K; };

struct StaticOrder {
    int nM, nN, nwg, G, c;
    __host__ __device__ void init(int M, int N, int G_, int c_) { nM = M / BM; nN = N / BM; nwg = nM * nN; G = G_; c = c_; }
    __host__ __device__ bool next(int i, Unit& u) const {
        const long L = (long)i * G + c; if (L >= nwg) return false;
        int wgid = (int)L; { const int q = nwg / NXCD, r = nwg % NXCD, xcd = wgid % NXCD, off = wgid / NXCD; wgid = (xcd < r ? xcd * (q + 1) : r * (q + 1) + (xcd - r) * q) + off; }
        const int nig = WGM * nN, gid = wgid / nig, fm = gid * WGM, gsz = (nM - fm) < WGM ? (nM - fm) : WGM;
        u.pm = fm + ((wgid % nig) % gsz); u.pn = (wgid % nig) / gsz; return true;
    }
    __device__ __forceinline__ void a_ready(const Unit&) const {}
    __device__ __forceinline__ void done(const Unit&) const {}
};

__device__ __forceinline__ unsigned cvt_pk_bf16(float lo, float hi) { unsigned r; asm volatile("v_cvt_pk_bf16_f32 %0, %1, %2" : "=v"(r) : "v"(lo), "v"(hi)); return r; }
struct EpiBf {
    static constexpr bool PERM = true, AFTER_DRAIN = false;
    bf16_t* O; int ldc; int act; float* flog; int flog_tile;
    __device__ __forceinline__ void operator()(const f32x4 (&acc)[2][2][4][2], const Unit& u, int wr, int wc, int fr, int fq) const {
        const int row0 = u.pm * BM + wr * 64 + fr;
        if (u.pn == flog_tile) {
            if (wc == 0 && fq == 0) {
#pragma unroll
                for (int ai = 0; ai < 2; ++ai)
#pragma unroll
                    for (int m = 0; m < 4; ++m) { float* p = flog + (size_t)(row0 + ai * HALF + m * 16) * 8; *(f32x4*)p = acc[ai][0][m][0]; *(f32x4*)(p + 4) = acc[ai][0][m][1]; }
            }
            return;
        }
        const int col0 = u.pn * BM + wc * 32 + 8 * fq;
#pragma unroll
        for (int ai = 0; ai < 2; ++ai)
#pragma unroll
            for (int m = 0; m < 4; ++m) { bf16_t* rowp = O + (size_t)(row0 + ai * HALF + m * 16) * ldc + col0;
#pragma unroll
                for (int bj = 0; bj < 2; ++bj) { f32x4 v0 = acc[ai][bj][m][0], v1 = acc[ai][bj][m][1];
                    if (act) {
#pragma unroll
                        for (int e = 0; e < 4; ++e) { float a = fmaxf(v0[e], 0.f), b = fmaxf(v1[e], 0.f); v0[e] = a * a; v1[e] = b * b; } }
                    u32x4 w; w.x = cvt_pk_bf16(v0[0], v0[1]); w.y = cvt_pk_bf16(v0[2], v0[3]); w.z = cvt_pk_bf16(v1[0], v1[1]); w.w = cvt_pk_bf16(v1[2], v1[3]);
                    *(u32x4*)(rowp + bj * HALF) = w; } }
    }
};
struct EpiResid {
    static constexpr bool PERM = false, AFTER_DRAIN = false;
    const float* base; float* out; int ldc;
    __device__ __forceinline__ void operator()(const f32x4 (&acc)[2][2][4][2], const Unit& u, int wr, int wc, int fr, int fq) const {
        const int col0 = u.pn * BM + wc * 32 + 4 * fq;
#pragma unroll
        for (int ai = 0; ai < 2; ++ai)
#pragma unroll
            for (int m = 0; m < 4; ++m) { const size_t off = (size_t)(u.pm * BM + ai * HALF + wr * 64 + m * 16 + fr) * ldc + col0;
#pragma unroll
                for (int bj = 0; bj < 2; ++bj)
#pragma unroll
                    for (int n = 0; n < 2; ++n) { const f32x4 bs = *(const f32x4*)(base + off + bj * HALF + n * 16); *(f32x4*)(out + off + bj * HALF + n * 16) = bs + acc[ai][bj][m][n]; }
                asm volatile("" ::: "memory"); }
    }
};
struct EpiGlu {
    static constexpr bool PERM = true, AFTER_DRAIN = false;
    const bf16_t* Gm; int ldg; bf16_t* O; int ldc;
    __device__ __forceinline__ void operator()(const f32x4 (&acc)[2][2][4][2], const Unit& u, int wr, int wc, int fr, int fq) const {
        const int row0 = u.pm * BM + wr * 64 + fr, col0 = u.pn * BM + wc * 32 + 8 * fq;
#pragma unroll
        for (int ai = 0; ai < 2; ++ai)
#pragma unroll
            for (int m = 0; m < 4; ++m) { const size_t r = (size_t)(row0 + ai * HALF + m * 16);
#pragma unroll
                for (int bj = 0; bj < 2; ++bj) { const u32x4 gv = *(const u32x4*)(Gm + r * ldg + col0 + bj * HALF);
                    const f32x4 v0 = acc[ai][bj][m][0], v1 = acc[ai][bj][m][1]; float o[8];
#pragma unroll
                    for (int e = 0; e < 4; ++e) { const unsigned w = gv[e]; const float g0 = __uint_as_float(w << 16), g1 = __uint_as_float(w & 0xffff0000u);
                        const float a0 = (e < 2) ? v0[2 * e] : v1[2 * e - 4], a1 = (e < 2) ? v0[2 * e + 1] : v1[2 * e - 3];
                        o[2 * e] = g0 / (1.f + __expf(-a0)); o[2 * e + 1] = g1 / (1.f + __expf(-a1)); }
                    u32x4 w; w.x = cvt_pk_bf16(o[0], o[1]); w.y = cvt_pk_bf16(o[2], o[3]); w.z = cvt_pk_bf16(o[4], o[5]); w.w = cvt_pk_bf16(o[6], o[7]);
                    *(u32x4*)(O + r * ldc + col0 + bj * HALF) = w; }
                asm volatile("" ::: "memory"); }
    }
};
template <class Epi, class Sched, bool ALIGN_EPI = false, bool SP2 = false>
__device__ __forceinline__ void gemm_phase(PG8_LAS unsigned char* lds, const Gemm g, const Sched& S, const Epi& E) {
    int tid_ = threadIdx.x; asm volatile("" : "+v"(tid_));
    const int tid = tid_, wid = __builtin_amdgcn_readfirstlane(tid >> 6), lane = tid & 63, wr = wid >> 2, wc = wid & 3, fr = lane & 15, fq = lane >> 4;
    const int K = g.K, nt = K / BK;
    unsigned voffA[2], voffB[2];
#pragma unroll
    for (int i = 0; i < 2; ++i) { int R, C; stage_rc(tid * 16 + i * 8192, R, C); const int Rb = Epi::PERM ? ((R & ~31) + perm32(R & 31)) : R;
        voffA[i] = (unsigned)(R * K + C) * 2u; voffB[i] = (unsigned)(Rb * K + C) * 2u; }
    const size_t kstep = (size_t)(BK * 2);
    const size_t hstep = (size_t)HALF * K * 2;
    const size_t tstep = 2 * hstep;
    const unsigned ldsw = (unsigned)wid * 1024u;
    const int aoff = lds_byte(wr * 64 + fr, fq * 8), boff = lds_byte(wc * 32 + fr, fq * 8);
#define PG8_SA(b, h) (((b) * 2 + (h)) * HTB)
#define PG8_SB(b, h) ((4 + (b) * 2 + (h)) * HTB)
#define PG8_STAGE(bufoff, gbase, voff) do { _Pragma("unroll") for (int _i = 0; _i < 2; ++_i) \
        __builtin_amdgcn_global_load_lds((const unsigned*)((const char*)(gbase) + (voff)[_i]), (PG8_LAS unsigned*)(lds + (bufoff) + ldsw + _i * 8192), 16, 0, PG8_AUX); } while (0)
#define PG8_LDA(dst, b, h) do { _Pragma("unroll") for (int m = 0; m < 4; ++m) _Pragma("unroll") for (int k = 0; k < 2; ++k) dst[m][k] = *(const PG8_LAS bf16x8*)(lds + PG8_SA(b, h) + aoff + m * 2048 + k * 1024); } while (0)
#define PG8_LDB(dst, b, h) do { _Pragma("unroll") for (int n = 0; n < 2; ++n) _Pragma("unroll") for (int k = 0; k < 2; ++k) dst[n][k] = *(const PG8_LAS bf16x8*)(lds + PG8_SB(b, h) + boff + n * 2048 + k * 1024); } while (0)
#define PG8_MMA(ai, bj, At, Bt) do { __builtin_amdgcn_s_setprio(1); _Pragma("unroll") for (int m = 0; m < 4; ++m) _Pragma("unroll") for (int n = 0; n < 2; ++n) _Pragma("unroll") for (int k = 0; k < 2; ++k) \
        acc[ai][bj][m][n] = __builtin_amdgcn_mfma_f32_16x16x32_bf16(Bt[n][k], At[m][k], acc[ai][bj][m][n], 0, 0, 0); __builtin_amdgcn_s_setprio(0); } while (0)
#ifdef DBG_DRAIN
#define PG8_WAIT_V(n) asm volatile("s_waitcnt vmcnt(0)" ::: "memory")
#else
#define PG8_WAIT_V(n) asm volatile("s_waitcnt vmcnt(" #n ")" ::: "memory")
#endif
#define PG8_WAIT_L(n) asm volatile("s_waitcnt lgkmcnt(" #n ")" ::: "memory")
#define PG8_BAR __builtin_amdgcn_s_barrier()
#define PG8_SCHED __builtin_amdgcn_sched_barrier(0)
    Unit cur, nxt; int ui = 0;
    if (!S.next(0, cur)) return;
    f32x4 acc[2][2][4][2];
#pragma unroll
    for (int a = 0; a < 2; ++a)
#pragma unroll
        for (int b = 0; b < 2; ++b)
#pragma unroll
            for (int m = 0; m < 4; ++m)
#pragma unroll
                for (int n = 0; n < 2; ++n) acc[a][b][m][n] = (f32x4){0.f, 0.f, 0.f, 0.f};
    bf16x8 At[4][2], B0[2][2], B1[2][2];
    const char* cA = (const char*)g.A + (size_t)cur.pm * tstep; const char* cB = (const char*)g.Bt + (size_t)cur.pn * tstep;
    S.a_ready(cur);
    if constexpr (SP2) {
        PG8_STAGE(PG8_SB(0, 0), cB, voffB); PG8_STAGE(PG8_SB(0, 1), cB + hstep, voffB); PG8_STAGE(PG8_SA(0, 0), cA, voffA); PG8_STAGE(PG8_SA(0, 1), cA + hstep, voffA);
        if (wr == 1) PG8_BAR;
        PG8_WAIT_V(2); PG8_BAR;
        PG8_STAGE(PG8_SB(1, 0), cB + kstep, voffB); PG8_STAGE(PG8_SA(1, 0), cA + kstep, voffA); PG8_STAGE(PG8_SB(1, 1), cB + hstep + kstep, voffB);
        PG8_WAIT_V(6); PG8_BAR;
    } else {
        PG8_STAGE(PG8_SB(0, 0), cB, voffB); PG8_STAGE(PG8_SA(0, 0), cA, voffA); PG8_STAGE(PG8_SB(0, 1), cB + hstep, voffB); PG8_STAGE(PG8_SA(0, 1), cA + hstep, voffA);
        if (wr == 1) PG8_BAR;
        PG8_WAIT_V(4); PG8_BAR;
        PG8_STAGE(PG8_SB(1, 0), cB + kstep, voffB); PG8_STAGE(PG8_SA(1, 0), cA + kstep, voffA); PG8_STAGE(PG8_SB(1, 1), cB + hstep + kstep, voffB);
        PG8_WAIT_V(6); PG8_BAR;
    }
    for (;;) {
        const bool has_next = S.next(ui + 1, nxt);
        const char* nA = has_next ? (const char*)g.A + (size_t)nxt.pm * tstep : cA; const char* nB = has_next ? (const char*)g.Bt + (size_t)nxt.pn * tstep : cB;
        for (int t = 0; t < nt; t += 2) {
            const bool last = (t == nt - 2);
            const char* a1 = cA + (size_t)(t + 1) * kstep;
            const char* a2 = last ? nA : cA + (size_t)(t + 2) * kstep; const char* b2 = last ? nB : cB + (size_t)(t + 2) * kstep;
            const char* a3 = a2 + kstep; const char* b3 = b2 + kstep;
            if (last && has_next) S.a_ready(nxt);
            if constexpr (SP2) {
            PG8_LDB(B0, 0, 0); PG8_LDB(B1, 0, 1); PG8_SCHED; PG8_LDA(At, 0, 0); PG8_STAGE(PG8_SA(1, 1), a1 + hstep, voffA);
            PG8_WAIT_V(8); PG8_WAIT_L(0); PG8_BAR; PG8_MMA(0, 0, At, B0); PG8_MMA(0, 1, At, B1); PG8_BAR; PG8_SCHED;
            PG8_LDA(At, 0, 1); PG8_STAGE(PG8_SB(0, 0), b2, voffB); PG8_STAGE(PG8_SB(0, 1), b2 + hstep, voffB); PG8_STAGE(PG8_SA(0, 0), a2, voffA);
            PG8_WAIT_V(8); PG8_WAIT_L(0); PG8_BAR; PG8_MMA(1, 0, At, B0); PG8_MMA(1, 1, At, B1); PG8_BAR; PG8_SCHED;
            PG8_LDB(B0, 1, 0); PG8_LDB(B1, 1, 1); PG8_SCHED; PG8_LDA(At, 1, 0); PG8_STAGE(PG8_SA(0, 1), a2 + hstep, voffA);
            PG8_WAIT_V(8); PG8_WAIT_L(0); PG8_BAR; PG8_MMA(0, 0, At, B0); PG8_MMA(0, 1, At, B1); PG8_BAR; PG8_SCHED;
            PG8_LDA(At, 1, 1); PG8_STAGE(PG8_SB(1, 0), b3, voffB); PG8_STAGE(PG8_SB(1, 1), b3 + hstep, voffB); PG8_STAGE(PG8_SA(1, 0), a3, voffA);
            PG8_WAIT_V(8); PG8_WAIT_L(0); PG8_BAR; PG8_MMA(1, 0, At, B0); PG8_MMA(1, 1, At, B1); PG8_BAR; PG8_SCHED;
            } else {
            PG8_LDB(B0, 0, 0); PG8_SCHED; PG8_LDA(At, 0, 0); PG8_STAGE(PG8_SA(1, 1), a1 + hstep, voffA);
            PG8_WAIT_L(8); PG8_BAR; PG8_WAIT_L(0); PG8_MMA(0, 0, At, B0); PG8_BAR; PG8_SCHED;
            PG8_LDB(B1, 0, 1); PG8_STAGE(PG8_SB(0, 0), b2, voffB);
            PG8_BAR; PG8_WAIT_L(0); PG8_MMA(0, 1, At, B1); PG8_BAR;
            PG8_LDA(At, 0, 1); PG8_STAGE(PG8_SA(0, 0), a2, voffA);
            PG8_BAR; PG8_WAIT_L(0); PG8_MMA(1, 0, At, B0); PG8_BAR; PG8_SCHED;
            PG8_STAGE(PG8_SB(0, 1), b2 + hstep, voffB);
            PG8_WAIT_V(6); PG8_BAR; PG8_MMA(1, 1, At, B1); PG8_BAR;
            PG8_LDB(B0, 1, 0); PG8_SCHED; PG8_LDA(At, 1, 0); PG8_STAGE(PG8_SA(0, 1), a2 + hstep, voffA);
            PG8_WAIT_L(8); PG8_BAR; PG8_WAIT_L(0); PG8_MMA(0, 0, At, B0); PG8_BAR; PG8_SCHED;
            PG8_LDB(B1, 1, 1); PG8_STAGE(PG8_SB(1, 0), b3, voffB);
            PG8_BAR; PG8_WAIT_L(0); PG8_MMA(0, 1, At, B1); PG8_BAR;
            PG8_LDA(At, 1, 1); PG8_STAGE(PG8_SA(1, 0), a3, voffA);
            PG8_BAR; PG8_WAIT_L(0); PG8_MMA(1, 0, At, B0); PG8_BAR; PG8_SCHED;
            PG8_STAGE(PG8_SB(1, 1), b3 + hstep, voffB);
            PG8_WAIT_V(6); PG8_BAR; PG8_MMA(1, 1, At, B1); PG8_BAR;
            }
        }
        if constexpr (ALIGN_EPI) { if (wr == 0) PG8_BAR; }
        if constexpr (!Epi::AFTER_DRAIN) { E(acc, cur, wr, wc, fr, fq); S.done(cur); }
        if (!has_next) break;
#pragma unroll
        for (int a = 0; a < 2; ++a)
#pragma unroll
            for (int b = 0; b < 2; ++b)
#pragma unroll
                for (int m = 0; m < 4; ++m)
#pragma unroll
                    for (int n = 0; n < 2; ++n) acc[a][b][m][n] = (f32x4){0.f, 0.f, 0.f, 0.f};
        cur = nxt; cA = nA; cB = nB; ++ui;
        if constexpr (ALIGN_EPI) { if (wr == 1) PG8_BAR; }
    }
    PG8_WAIT_V(0);
    if constexpr (!ALIGN_EPI) { if (wr == 0) PG8_BAR; }
    PG8_BAR;
    if constexpr (Epi::AFTER_DRAIN) { E.fused(acc, cur, wr, wc, fr, fq, lds, wid, lane); S.done(cur); }
#undef PG8_SA
#undef PG8_SB
#undef PG8_STAGE
#undef PG8_LDA
#undef PG8_LDB
#undef PG8_MMA
#undef PG8_WAIT_V
#undef PG8_WAIT_L
#undef PG8_BAR
#undef PG8_SCHED
}
}
#ifndef MK_ONE_LAUNCH
#define MK_ONE_LAUNCH 1
#endif
#define LAS __attribute__((address_space(3)))
typedef unsigned short bf16;
typedef short bf16x8 __attribute__((ext_vector_type(8)));
typedef short bf16x4 __attribute__((ext_vector_type(4)));
typedef float f32x4 __attribute__((ext_vector_type(4)));
typedef unsigned u32x4 __attribute__((ext_vector_type(4)));
typedef unsigned u32x2 __attribute__((ext_vector_type(2)));

constexpr int NB = 4, SEQ = 4096, DM = 2048, NT = NB * SEQ, DEPTH = 4;
constexpr int EVEN_IN = 7176, EVEN_N = 7424, EVEN_LD = 7168, ODD_IN = 4096, DFF = 8192, XAW = 512, MEML = 256;
constexpr float EPS = 1e-6f;
constexpr float LOG2E = 1.4426950408889634f;
constexpr float QK_SCALE = 0.08838834764831845f;

constexpr size_t MiB = 1u << 20;
constexpr size_t WS_H = 1 * MiB;
constexpr size_t WS_XN = WS_H + 128 * MiB;
constexpr size_t WS_PROJ = WS_XN + 64 * MiB;
constexpr size_t WS_MIX = WS_PROJ + 256 * MiB;
constexpr size_t WS_VT = WS_MIX + 64 * MiB;
constexpr size_t WS_QX = WS_VT + 64 * MiB;
constexpr size_t WS_XO = WS_QX + 16 * MiB;
constexpr size_t WS_FLOG = WS_XO + 16 * MiB;
constexpr size_t WS_C2 = WS_FLOG + 1 * MiB;
constexpr size_t WS_MEMN = WS_C2 + 1 * MiB;
constexpr size_t WS_KVX = WS_MEMN + 4 * MiB;
constexpr size_t WS_VTX = WS_KVX + 8 * MiB;
constexpr size_t WS_ROPE = WS_VTX + 4 * MiB;
constexpr size_t WS_WKVT = WS_ROPE + 2 * MiB;
constexpr size_t WS_WINT = WS_WKVT + 16 * MiB;
constexpr size_t WS_WOUTT = WS_WINT + 30 * MiB;
constexpr size_t WS_WQT = WS_WOUTT + 8 * MiB;
constexpr size_t WS_WOT = WS_WQT + 2 * MiB;
constexpr size_t WS_W1T = WS_WOT + 2 * MiB;
constexpr size_t WS_W2T = WS_W1T + 32 * MiB;
constexpr size_t WS_WGLUT = WS_W2T + 32 * MiB;
constexpr size_t WS_END = WS_WGLUT + 2 * MiB;

constexpr int LDS_BYTES = 147456;

__device__ __forceinline__ unsigned f2bf(float f) { unsigned u = __builtin_bit_cast(unsigned, f); return (u + 0x7fffu + ((u >> 16) & 1u)) >> 16; }
__device__ __forceinline__ unsigned pk2(float lo, float hi) { return f2bf(lo) | (f2bf(hi) << 16); }
__device__ __forceinline__ float bflo(unsigned w) { return __uint_as_float(w << 16); }
__device__ __forceinline__ float bfhi(unsigned w) { return __uint_as_float(w & 0xffff0000u); }
__device__ __forceinline__ float wave_sum(float v) {
#pragma unroll
    for (int o = 1; o < 64; o <<= 1) v += __shfl_xor(v, o);
    return v;
}
#define LDS_FENCE() do { asm volatile("s_waitcnt lgkmcnt(0)" ::: "memory"); __builtin_amdgcn_wave_barrier(); } while (0)

struct Args { const float* in[27]; float* out; unsigned char* ws; int ph_lo, ph_hi; };

__device__ __forceinline__ void tr_item(const float* __restrict__ W, int ldw, int K, int col0, bf16* __restrict__ WT, int drow0, int k0, LAS float* scr, int lane) {
#pragma unroll 8
    for (int i = 0; i < 32; ++i) { const int kk = 2 * i + (lane >> 5); scr[kk * 33 + (lane & 31)] = W[(size_t)(k0 + kk) * ldw + col0 + (lane & 31)]; }
    LDS_FENCE();
    const int c = lane & 7;
#pragma unroll
    for (int j = 0; j < 4; ++j) { const int n = (lane >> 3) + 8 * j; const LAS float* s = scr + (8 * c) * 33 + n;
        u32x4 o; o.x = pk2(s[0 * 33], s[1 * 33]); o.y = pk2(s[2 * 33], s[3 * 33]); o.z = pk2(s[4 * 33], s[5 * 33]); o.w = pk2(s[6 * 33], s[7 * 33]);
        *(u32x4*)(WT + (size_t)(drow0 + n) * K + k0 + 8 * c) = o; }
    LDS_FENCE();
}
__device__ __forceinline__ void tr_matrix(const float* W, int ldw, int K, int col_off, int ncols, bf16* WT, int row_off, LAS float* scr, int gw, int NGW, int lane) {
    const int nblk = ncols / 32, nitems = (K / 64) * nblk;
    for (int it = gw; it < nitems; it += NGW) { const int kb = it / nblk, nb = it - kb * nblk; tr_item(W, ldw, K, col_off + 32 * nb, WT, row_off + 32 * nb, 64 * kb, scr, lane); }
}
__device__ __forceinline__ void rms_row(const float* __restrict__ xrow, const float* __restrict__ gain, bf16* orow, float* of32, int lane) {
    const f32x4* xr = (const f32x4*)xrow + lane; const f32x4* gr = (const f32x4*)gain + lane;
    f32x4 v[8]; float s = 0.f;
#pragma unroll
    for (int j = 0; j < 8; ++j) { v[j] = xr[64 * j]; s += (v[j].x * v[j].x + v[j].y * v[j].y) + (v[j].z * v[j].z + v[j].w * v[j].w); }
    const float r = rsqrtf(wave_sum(s) * (1.f / DM) + EPS);
    if (of32) {
#pragma unroll
        for (int j = 0; j < 8; ++j) { const f32x4 g = gr[64 * j]; ((f32x4*)of32 + lane)[64 * j] = v[j] * r * g; }
    } else {
        u32x2* o8 = (u32x2*)orow + lane;
#pragma unroll
        for (int j = 0; j < 8; ++j) { const f32x4 g = gr[64 * j]; const f32x4 y = v[j] * r * g; u32x2 w; w.x = pk2(y.x, y.y); w.y = pk2(y.z, y.w); o8[64 * j] = w; }
    }
}
__device__ __forceinline__ void rms_rows(const float* X, const float* gain, bf16* O, float* OF, int nrows, int gw, int NGW, int lane) {
    for (int m = gw; m < nrows; m += NGW) rms_row(X + (size_t)m * DM, gain, O ? O + (size_t)m * DM : nullptr, OF ? OF + (size_t)m * DM : nullptr, lane);
}

__device__ __forceinline__ void tr_bf16_64x64(const bf16* __restrict__ src, size_t lds_, bf16* __restrict__ dst, size_t ldd, LAS unsigned char* scr, int lane) {
#pragma unroll
    for (int i = 0; i < 8; ++i) { const int id = i * 64 + lane, r = id >> 3, ch = id & 7;
        const u32x4 v = *(const u32x4*)(src + (size_t)r * lds_ + ch * 8);
#pragma unroll
        for (int e = 0; e < 4; ++e) { const unsigned w = v[e]; const int c = ch * 8 + 2 * e;
            *(LAS unsigned short*)(scr + c * 144 + r * 2) = (unsigned short)(w & 0xffffu); *(LAS unsigned short*)(scr + (c + 1) * 144 + r * 2) = (unsigned short)(w >> 16); } }
    LDS_FENCE();
#pragma unroll
    for (int i = 0; i < 8; ++i) { const int id = i * 64 + lane, c = id >> 3, ch = id & 7;
        const u32x4 v = *(const LAS u32x4*)(scr + c * 144 + ch * 16);
        *(u32x4*)(dst + (size_t)c * ldd + ch * 8) = v; }
    LDS_FENCE();
}
constexpr int AT_KP = 272, AT_VP = 144, AT_KB = 64 * AT_KP, AT_VB = 128 * AT_VP;
constexpr int AT_VOFF = 2 * AT_KB;
template <int MODE>
__device__ __forceinline__ void attn_unit(LAS unsigned char* lds, const bf16* __restrict__ Qp, int ldq, const bf16* __restrict__ Kp, int ldk, const bf16* __restrict__ VTp, int ldvt,
                                          bf16* __restrict__ Op, int ldo, int q0, int nkeys, const float* __restrict__ c2, float l2g, const bf16* __restrict__ gate) {
    int tid_ = threadIdx.x; asm volatile("" : "+v"(tid_));
    const int tid = tid_, w = __builtin_amdgcn_readfirstlane(tid >> 6), lane = tid & 63, g4 = lane >> 4, c16 = lane & 15;
    const int ntiles = (MODE == 2) ? (nkeys >> 6) : ((q0 + 256) >> 6);
    const int qw0 = q0 + w * 32;
    const int tmax = (MODE == 2) ? ntiles - 1 : ((qw0 + 31) >> 6);
    __syncthreads();
    bf16x8 qf[2][4];
#pragma unroll
    for (int qs = 0; qs < 2; ++qs)
#pragma unroll
        for (int dk = 0; dk < 4; ++dk) qf[qs][dk] = *(const bf16x8*)(Qp + (size_t)(qw0 + qs * 16 + c16) * ldq + dk * 32 + g4 * 8);
    float cq[2] = {0.f, 0.f};
    if (MODE == 0) { cq[0] = c2[qw0 + c16]; cq[1] = c2[qw0 + 16 + c16]; }
    const int kr0 = tid >> 4, kc = tid & 15;
    const int vr0 = tid >> 3, vc = tid & 7;
    u32x4 kreg[2], vreg[2];
#define AT_LOAD(t) do { \
        kreg[0] = *(const u32x4*)(Kp + (size_t)((t) * 64 + kr0) * ldk + kc * 8); kreg[1] = *(const u32x4*)(Kp + (size_t)((t) * 64 + kr0 + 32) * ldk + kc * 8); \
        vreg[0] = *(const u32x4*)(VTp + (size_t)vr0 * ldvt + (t) * 64 + vc * 8); vreg[1] = *(const u32x4*)(VTp + (size_t)(vr0 + 64) * ldvt + (t) * 64 + vc * 8); } while (0)
#define AT_STORE(b) do { \
        *(LAS u32x4*)(lds + (b) * AT_KB + kr0 * AT_KP + kc * 16) = kreg[0]; *(LAS u32x4*)(lds + (b) * AT_KB + (kr0 + 32) * AT_KP + kc * 16) = kreg[1]; \
        *(LAS u32x4*)(lds + AT_VOFF + (b) * AT_VB + vr0 * AT_VP + vc * 16) = vreg[0]; *(LAS u32x4*)(lds + AT_VOFF + (b) * AT_VB + (vr0 + 64) * AT_VP + vc * 16) = vreg[1]; } while (0)
    f32x4 O[8][2];
#pragma unroll
    for (int db = 0; db < 8; ++db) { O[db][0] = (f32x4){0.f, 0.f, 0.f, 0.f}; O[db][1] = (f32x4){0.f, 0.f, 0.f, 0.f}; }
    float mrun[2] = {-INFINITY, -INFINITY}, lsum[2] = {0.f, 0.f};
    AT_LOAD(0); AT_STORE(0);
    __syncthreads();
    for (int t = 0; t < ntiles; ++t) {
        const int cur = t & 1;
        if (t + 1 < ntiles) AT_LOAD(t + 1);
        if (t <= tmax) {
            const LAS unsigned char* Ks = lds + cur * AT_KB; const LAS unsigned char* Vs = lds + AT_VOFF + cur * AT_VB;
            f32x4 S[4][2];
#pragma unroll
            for (int kb = 0; kb < 4; ++kb) { S[kb][0] = (f32x4){0.f, 0.f, 0.f, 0.f}; S[kb][1] = (f32x4){0.f, 0.f, 0.f, 0.f};
#pragma unroll
                for (int dk = 0; dk < 4; ++dk) { const bf16x8 kf = *(const LAS bf16x8*)(Ks + (kb * 16 + c16) * AT_KP + dk * 64 + g4 * 16);
                    S[kb][0] = __builtin_amdgcn_mfma_f32_16x16x32_bf16(kf, qf[0][dk], S[kb][0], 0, 0, 0);
                    S[kb][1] = __builtin_amdgcn_mfma_f32_16x16x32_bf16(kf, qf[1][dk], S[kb][1], 0, 0, 0); } }
            const int kbase = t * 64 + g4 * 4;
            if (MODE == 1) {
#pragma unroll
                for (int qs = 0; qs < 2; ++qs) { const int qpos = qw0 + qs * 16 + c16;
#pragma unroll
                    for (int kb = 0; kb < 4; ++kb)
#pragma unroll
                        for (int j = 0; j < 4; ++j) { const int dd = qpos - (kbase + kb * 16 + j);
                            const float dec = __builtin_amdgcn_exp2f(l2g * (float)dd);
                            S[kb][qs][j] = (dd >= 0) ? S[kb][qs][j] * dec : 0.f; } }
            } else {
                f32x4 ck[4];
                if (MODE == 0) {
#pragma unroll
                    for (int kb = 0; kb < 4; ++kb) ck[kb] = *(const f32x4*)(c2 + kbase + kb * 16);
                }
#pragma unroll
                for (int qs = 0; qs < 2; ++qs) { const int qpos = qw0 + qs * 16 + c16; float mx = -INFINITY;
#pragma unroll
                    for (int kb = 0; kb < 4; ++kb)
#pragma unroll
                        for (int j = 0; j < 4; ++j) { float s = S[kb][qs][j] * (QK_SCALE * LOG2E);
                            if (MODE == 0) { s += cq[qs] - ck[kb][j]; if (kbase + kb * 16 + j > qpos) s = -INFINITY; }
                            S[kb][qs][j] = s; mx = fmaxf(mx, s); }
                    mx = fmaxf(mx, __shfl_xor(mx, 16)); mx = fmaxf(mx, __shfl_xor(mx, 32));
                    const float mnew = fmaxf(mrun[qs], mx);
                    const float alpha = __builtin_amdgcn_exp2f(mrun[qs] - mnew);
                    mrun[qs] = mnew; float ps = 0.f;
#pragma unroll
                    for (int kb = 0; kb < 4; ++kb)
#pragma unroll
                        for (int j = 0; j < 4; ++j) { const float p = __builtin_amdgcn_exp2f(S[kb][qs][j] - mnew); S[kb][qs][j] = p; ps += p; }
                    lsum[qs] = lsum[qs] * alpha + ps;
#pragma unroll
                    for (int db = 0; db < 8; ++db) O[db][qs] = O[db][qs] * alpha; }
            }
#pragma unroll
            for (int k2 = 0; k2 < 2; ++k2) {
                bf16x8 pb[2];
#pragma unroll
                for (int qs = 0; qs < 2; ++qs) { u32x4 pw; pw.x = pk2(S[2 * k2][qs][0], S[2 * k2][qs][1]); pw.y = pk2(S[2 * k2][qs][2], S[2 * k2][qs][3]);
                    pw.z = pk2(S[2 * k2 + 1][qs][0], S[2 * k2 + 1][qs][1]); pw.w = pk2(S[2 * k2 + 1][qs][2], S[2 * k2 + 1][qs][3]); pb[qs] = __builtin_bit_cast(bf16x8, pw); }
#pragma unroll
                for (int db = 0; db < 8; ++db) { const LAS unsigned char* vp = Vs + (db * 16 + c16) * AT_VP + k2 * 64 + g4 * 8;
                    const u32x2 v0 = *(const LAS u32x2*)vp, v1 = *(const LAS u32x2*)(vp + 32);
                    u32x4 vw; vw.x = v0.x; vw.y = v0.y; vw.z = v1.x; vw.w = v1.y; const bf16x8 vf = __builtin_bit_cast(bf16x8, vw);
                    O[db][0] = __builtin_amdgcn_mfma_f32_16x16x32_bf16(vf, pb[0], O[db][0], 0, 0, 0);
                    O[db][1] = __builtin_amdgcn_mfma_f32_16x16x32_bf16(vf, pb[1], O[db][1], 0, 0, 0); }
            }
        }
        if (t + 1 < ntiles) AT_STORE(cur ^ 1);
        __syncthreads();
    }
#undef AT_LOAD
#undef AT_STORE
#pragma unroll
    for (int qs = 0; qs < 2; ++qs) {
        if (MODE == 1) {
            float s = 0.f;
#pragma unroll
            for (int db = 0; db < 8; ++db) s += (O[db][qs][0] + O[db][qs][1]) + (O[db][qs][2] + O[db][qs][3]);
            s += __shfl_xor(s, 16); s += __shfl_xor(s, 32);
            const float mu = s * (1.f / 128.f); float q = 0.f;
#pragma unroll
            for (int db = 0; db < 8; ++db) { O[db][qs] = O[db][qs] - mu; q += (O[db][qs][0] * O[db][qs][0] + O[db][qs][1] * O[db][qs][1]) + (O[db][qs][2] * O[db][qs][2] + O[db][qs][3] * O[db][qs][3]); }
            q += __shfl_xor(q, 16); q += __shfl_xor(q, 32);
            const float rs = rsqrtf(q * (1.f / 128.f) + EPS);
#pragma unroll
            for (int db = 0; db < 8; ++db) O[db][qs] = O[db][qs] * rs;
        } else {
            float l = lsum[qs]; l += __shfl_xor(l, 16); l += __shfl_xor(l, 32);
            const float inv = 1.f / l;
#pragma unroll
            for (int db = 0; db < 8; ++db) O[db][qs] = O[db][qs] * inv;
        }
    }
    LAS unsigned char* Os = lds + w * (32 * AT_KP);
#pragma unroll
    for (int qs = 0; qs < 2; ++qs)
#pragma unroll
        for (int db = 0; db < 8; ++db) { u32x2 wv; wv.x = pk2(O[db][qs][0], O[db][qs][1]); wv.y = pk2(O[db][qs][2], O[db][qs][3]);
            *(LAS u32x2*)(Os + (qs * 16 + c16) * AT_KP + (db * 16 + g4 * 4) * 2) = wv; }
    LDS_FENCE();
#pragma unroll
    for (int i = 0; i < 8; ++i) { const int id = i * 64 + lane, r = id >> 4, ch = id & 15;
        u32x4 v = *(const LAS u32x4*)(Os + r * AT_KP + ch * 16);
        if (MODE == 1) { const u32x4 gv = *(const u32x4*)(gate + (size_t)(qw0 + r) * ldq + ch * 8);
#pragma unroll
            for (int e = 0; e < 4; ++e) { const float g0 = bflo(gv[e]), g1 = bfhi(gv[e]);
                const float o0 = bflo(v[e]) * (g0 / (1.f + __expf(-g0))), o1 = bfhi(v[e]) * (g1 / (1.f + __expf(-g1))); v[e] = pk2(o0, o1); } }
        *(u32x4*)(Op + (size_t)(qw0 + r) * ldo + ch * 8) = v; }
}
constexpr int S5_BUP = 80;
constexpr int S5_WAVE = 128 * S5_BUP + 16 * 272;
constexpr int S5_XCH = 8 * S5_WAVE;
struct S5P { const float *a_re, *a_im, *b_re, *b_im, *c_re, *c_im, *dsk, *lstep; };
__device__ __forceinline__ void s5_abar(const S5P& P, int g, int p, float& ar, float& ai, float& cr, float& ci) {
    const float lr = fminf(P.a_re[g * 64 + p], -1e-4f), li = P.a_im[g * 64 + p], st = __expf(P.lstep[g * 64 + p]);
    const float zr = lr * st, zi = li * st, mag = __expf(zr);
    const float rev = zi * 0.15915494309189535f; const float fr = rev - floorf(rev);
    ar = mag * __builtin_amdgcn_cosf(fr); ai = mag * __builtin_amdgcn_sinf(fr);
    const float nr = ar - 1.f, ni = ai, den = 1.f / (lr * lr + li * li);
    cr = (nr * lr + ni * li) * den; ci = (ni * lr - nr * li) * den;
}
__device__ __forceinline__ float gelu_tanh(float y) {
    const float u = 0.7978845608028654f * (y + 0.044715f * y * y * y);
    const float t = __builtin_amdgcn_exp2f(u * (2.f * LOG2E));
    const float th = 1.f - 2.f / (t + 1.f);
    return 0.5f * y * (1.f + th);
}
__device__ __forceinline__ void s5_unit(LAS unsigned char* lds, int b, int g, const bf16* __restrict__ PROJ, bf16* __restrict__ GB, const S5P& P) {
    int tid_ = threadIdx.x; asm volatile("" : "+v"(tid_));
    const int tid = tid_, w = __builtin_amdgcn_readfirstlane(tid >> 6), lane = tid & 63, g4 = lane >> 4, c16 = lane & 15;
    LAS unsigned char* Bs = lds + w * S5_WAVE; LAS unsigned char* Xs = Bs + 128 * S5_BUP; LAS float* xch = (LAS float*)(lds + S5_XCH);
    __syncthreads();
    float ar, ai, tcr, tci; s5_abar(P, g, lane, ar, ai, tcr, tci);
    bf16x8 Bb[8];
#pragma unroll
    for (int q = 0; q < 4; ++q) { const int pp = q * 16 + c16; float a0, a1, cr, ci; s5_abar(P, g, pp, a0, a1, cr, ci);
        unsigned wr_[4], wi_[4];
#pragma unroll
        for (int e = 0; e < 4; ++e) { float re[2], im[2];
#pragma unroll
            for (int h = 0; h < 2; ++h) { const int c = (g4 & 1) * 8 + 2 * e + h; const float br = P.b_re[((size_t)g * 64 + pp) * 16 + c], bi = P.b_im[((size_t)g * 64 + pp) * 16 + c];
                re[h] = cr * br - ci * bi; im[h] = cr * bi + ci * br; }
            wr_[e] = (g4 < 2) ? pk2(re[0], re[1]) : 0u; wi_[e] = (g4 < 2) ? pk2(im[0], im[1]) : 0u; }
        u32x4 a; a.x = wr_[0]; a.y = wr_[1]; a.z = wr_[2]; a.w = wr_[3]; Bb[q] = __builtin_bit_cast(bf16x8, a);
        u32x4 c; c.x = wi_[0]; c.y = wi_[1]; c.z = wi_[2]; c.w = wi_[3]; Bb[4 + q] = __builtin_bit_cast(bf16x8, c); }
    bf16x8 Cb[4];
#pragma unroll
    for (int kb = 0; kb < 4; ++kb) { unsigned wv[4];
#pragma unroll
        for (int e = 0; e < 4; ++e) { const int pidx = kb * 16 + g4 * 4 + e; const size_t ix = ((size_t)g * 16 + c16) * 64 + pidx; wv[e] = pk2(P.c_re[ix], -P.c_im[ix]); }
        u32x4 a; a.x = wv[0]; a.y = wv[1]; a.z = wv[2]; a.w = wv[3]; Cb[kb] = __builtin_bit_cast(bf16x8, a); }
    const float dsk = P.dsk[g * 16 + c16];
    const bf16* urow = PROJ + (size_t)(b * SEQ) * ODD_IN + g * 16;
    float xr = 0.f, xi = 0.f;
    for (int pass = 0; pass < 2; ++pass) {
        for (int blk = 0; blk < 32; ++blk) {
            const int tok0 = w * 512 + blk * 16;
            u32x4 uw = (u32x4){0u, 0u, 0u, 0u};
            if (g4 < 2) uw = *(const u32x4*)(urow + (size_t)(tok0 + c16) * ODD_IN + g4 * 8);
            const bf16x8 ua = __builtin_bit_cast(bf16x8, uw);
#pragma unroll
            for (int nb = 0; nb < 8; ++nb) { f32x4 acc = (f32x4){0.f, 0.f, 0.f, 0.f};
                acc = __builtin_amdgcn_mfma_f32_16x16x32_bf16(ua, Bb[nb], acc, 0, 0, 0);
                *(LAS f32x4*)(Bs + (nb * 16 + c16) * S5_BUP + g4 * 16) = acc; }
            __syncthreads();
#pragma unroll
            for (int k = 0; k < 4; ++k) { const f32x4 br = *(const LAS f32x4*)(Bs + lane * S5_BUP + k * 16), bi = *(const LAS f32x4*)(Bs + (64 + lane) * S5_BUP + k * 16);
#pragma unroll
                for (int j = 0; j < 4; ++j) { const float nr = ar * xr - ai * xi + br[j], ni = ar * xi + ai * xr + bi[j]; xr = nr; xi = ni;
                    if (pass == 1) *(LAS unsigned*)(Xs + (k * 4 + j) * 272 + lane * 4) = pk2(xr, xi); } }
            if (pass == 1) {
                __syncthreads();
                f32x4 y = (f32x4){0.f, 0.f, 0.f, 0.f};
#pragma unroll
                for (int kb = 0; kb < 4; ++kb) { const bf16x8 xa = *(const LAS bf16x8*)(Xs + c16 * 272 + kb * 64 + g4 * 16); y = __builtin_amdgcn_mfma_f32_16x16x32_bf16(xa, Cb[kb], y, 0, 0, 0); }
#pragma unroll
                for (int j = 0; j < 4; ++j) { const int tok = tok0 + g4 * 4 + j; const float u = __uint_as_float((unsigned)urow[(size_t)tok * ODD_IN + c16] << 16);
                    const float v = gelu_tanh(y[j] + dsk * u);
                    GB[(size_t)(b * SEQ + tok) * 1024 + g * 16 + c16] = (bf16)f2bf(v); }
            }
            __syncthreads();
        }
        if (pass == 0) {
            xch[(w * 64 + lane) * 2] = xr; xch[(w * 64 + lane) * 2 + 1] = xi;
            __syncthreads();
            float pr = ar, pi = ai;
#pragma unroll
            for (int s = 0; s < 9; ++s) { const float nr = pr * pr - pi * pi, ni = 2.f * pr * pi; pr = nr; pi = ni; }
            xr = 0.f; xi = 0.f;
            for (int j = 0; j < w; ++j) { const float er = xch[(j * 64 + lane) * 2], ei = xch[(j * 64 + lane) * 2 + 1];
                const float nr = pr * xr - pi * xi + er, ni = pr * xi + pi * xr + ei; xr = nr; xi = ni; }
        }
    }
}
#define x_in IN(0)
#define H ((float*)(ws + WS_H))
#define XN ((bf16*)(ws + WS_XN))
#define PROJ ((bf16*)(ws + WS_PROJ))
#define MIX ((bf16*)(ws + WS_MIX))
#define VT ((bf16*)(ws + WS_VT))
#define GB ((bf16*)(ws + WS_VT))
#define QX ((bf16*)(ws + WS_QX))
#define XO ((bf16*)(ws + WS_XO))
#define FLOG ((float*)(ws + WS_FLOG))
#define C2 ((float*)(ws + WS_C2))
#define MEMN ((bf16*)(ws + WS_MEMN))
#define KVX ((bf16*)(ws + WS_KVX))
#define VTX ((bf16*)(ws + WS_VTX))
#define ROPE ((float*)(ws + WS_ROPE))
#define WKVT ((bf16*)(ws + WS_WKVT))
#define WINT ((bf16*)(ws + WS_WINT))
#define WOUTT ((bf16*)(ws + WS_WOUTT))
#define WQT ((bf16*)(ws + WS_WQT))
#define WOT ((bf16*)(ws + WS_WOT))
#define W1T ((bf16*)(ws + WS_W1T))
#define W2T ((bf16*)(ws + WS_W2T))
#define WGLUT ((bf16*)(ws + WS_WGLUT))
#define IN(i) (args.in[(i) + zz])
#define run_gemm(lds, ...) run_gemm_(lds, G, bid, __VA_ARGS__)
constexpr int PH_PER_LAYER = 12, N_PHASES = DEPTH * PH_PER_LAYER + 1;
using GOrder = pg8::StaticOrder;
template <class Epi> __device__ __forceinline__ void run_gemm_(LAS unsigned char* lds, int G, int bid, const bf16* A, const bf16* Bt, int M, int N, int K, const Epi& E) {
    pg8::Gemm g{A, Bt, M, N, K}; GOrder S; S.init(M, N, G, bid);
#ifndef NO_GEMM
    pg8::gemm_phase<Epi, GOrder, true, true>(lds, g, S, E);
#endif
}

__device__ __forceinline__ void grid_bar(unsigned* cnt, unsigned target) {
#ifdef DBG_DELAY
    { const unsigned long long t0 = __builtin_amdgcn_s_memrealtime(); while (__builtin_amdgcn_s_memrealtime() - t0 < (unsigned long long)DBG_DELAY) __builtin_amdgcn_s_sleep(8); }
#endif
    asm volatile("s_waitcnt vmcnt(0) lgkmcnt(0)" ::: "memory");
    __syncthreads();
    if (threadIdx.x == 0) {
        __builtin_amdgcn_fence(__ATOMIC_RELEASE, "");
        asm volatile("s_waitcnt vmcnt(0)" ::: "memory");
        __hip_atomic_fetch_add(cnt, 1u, __ATOMIC_RELAXED, __HIP_MEMORY_SCOPE_AGENT);
        while (__hip_atomic_load(cnt, __ATOMIC_RELAXED, __HIP_MEMORY_SCOPE_AGENT) < target) __builtin_amdgcn_s_sleep(1);
        __builtin_amdgcn_fence(__ATOMIC_ACQUIRE, "");
        asm volatile("s_waitcnt vmcnt(0)" ::: "memory");
    }
    __syncthreads();
}
__global__ void __launch_bounds__(512, 2) trunk_fwd(Args args) {
    extern __shared__ __attribute__((aligned(16))) unsigned char lds_raw[];
    LAS unsigned char* lds = (LAS unsigned char*)lds_raw;
    cg::grid_group grid = cg::this_grid();
    const int lo = args.ph_lo, hi = args.ph_hi;
    int ph = 0; unsigned nbar = 0;
#ifdef DBG_LDSFILL
    for (int i = threadIdx.x; i < LDS_BYTES / 16; i += 512) ((LAS u32x4*)lds)[i] = (u32x4){0u, 0u, 0u, 0u};
    __syncthreads();
#endif
#ifdef DBG_FILL
    { u32x4* p = (u32x4*)(args.ws + MiB); const size_t n = (WS_END - MiB) / 16; for (size_t i = (size_t)blockIdx.x * 512 + threadIdx.x; i < n; i += (size_t)gridDim.x * 512) p[i] = (u32x4){0u, 0u, 0u, 0u}; }
#endif
    if (hi - lo > 1) grid.sync();
#ifndef DBG_NPH
#define DBG_NPH 1000
#endif
#define PH_BEGIN if (ph >= lo && ph < hi && (ph < DBG_NPH || ph == N_PHASES - 1)) { unsigned char* ws = args.ws; int zz = 0; int tid = threadIdx.x; int G = gridDim.x; int bid = blockIdx.x; asm volatile("" : "+s"(ws), "+s"(zz), "+v"(tid), "+s"(G), "+s"(bid)); const int lane = tid & 63, wave = __builtin_amdgcn_readfirstlane(tid >> 6), gw = bid * 8 + wave, NGW = G * 8; (void)lane; (void)gw; (void)NGW;
#define PH_END } if (ph >= lo && ph + 1 < hi) { ++nbar; grid_bar((unsigned*)args.ws, nbar * gridDim.x); } ++ph;

#ifdef DBG_COPYX
    { const float* xs = args.in[0]; for (size_t i = (size_t)blockIdx.x * 512 + threadIdx.x; i < (size_t)NT * DM; i += (size_t)gridDim.x * 512) args.out[i] = xs[i]; return; }
#endif
#ifdef DBG_BARTEST
    { float* flag = (float*)(args.ws + 512 * 1024);
      if (blockIdx.x == 5) { const unsigned long long t0 = __builtin_amdgcn_s_memrealtime(); while (__builtin_amdgcn_s_memrealtime() - t0 < 300000ull) __builtin_amdgcn_s_sleep(8);
          if (threadIdx.x == 0) flag[0] = 1234.5f; }
#if DBG_BARTEST == 1
      ++nbar; grid_bar((unsigned*)args.ws, nbar * gridDim.x);
#else
      grid.sync();
#endif
      const float f = __hip_atomic_load(flag, __ATOMIC_RELAXED, __HIP_MEMORY_SCOPE_AGENT);
      for (size_t i = (size_t)blockIdx.x * 512 + threadIdx.x; i < (size_t)NT * DM; i += (size_t)gridDim.x * 512) args.out[i] = f;
      return; }
#endif
#pragma unroll 1
    for (int layer = 0; layer < DEPTH; ++layer) {
        const bool even = (layer & 1) == 0;
#ifdef DBG_SUB0
        const int sub = 0;
#else
        const int sub = layer >> 1;
#endif
        PH_BEGIN
            LAS float* scr = (LAS float*)(lds + wave * 16384);
            if (layer == 0) {
                rms_rows(IN(1), IN(5), MEMN, nullptr, NB * MEML, gw, NGW, lane);
                for (int l = 0; l < DEPTH; ++l) tr_matrix(IN(23) + (size_t)l * DM * 1024, 1024, DM, 0, 1024, WKVT, l * 1024, scr, gw, NGW, lane);
                for (int idx = bid * 512 + tid; idx < SEQ * 64; idx += G * 512) { const int pos = idx >> 6, i = idx & 63;
                    const float inv = powf(10000.f, -(float)i * (1.f / 64.f)); const float ang = (float)pos * inv;
                    const double rev = (double)ang * 0.15915494309189535; const float fr = (float)(rev - floor(rev));
                    ROPE[idx] = __builtin_amdgcn_cosf(fr); ROPE[SEQ * 64 + idx] = __builtin_amdgcn_sinf(fr); }
            }
            if (even) {
                const float* Win = IN(7) + (size_t)sub * DM * EVEN_IN;
                tr_matrix(Win, EVEN_IN, DM, 0, 3072, WINT, 0, scr, gw, NGW, lane);
                tr_matrix(Win, EVEN_IN, DM, 3080, 4096, WINT, 3072, scr, gw, NGW, lane);
                for (int idx = gw * 64 + lane; idx < 8 * DM; idx += NGW * 64) { const int n = idx >> 11, k = idx & 2047; WINT[(size_t)(7168 + n) * DM + k] = (bf16)f2bf(Win[(size_t)k * EVEN_IN + 3072 + n]); }
                for (int idx = gw * 64 + lane; idx < 248 * DM / 8; idx += NGW * 64) *((u32x4*)(WINT + (size_t)7176 * DM) + idx) = (u32x4){0u, 0u, 0u, 0u};
                tr_matrix(IN(9) + (size_t)sub * DM * DM, DM, DM, 0, DM, WOUTT, 0, scr, gw, NGW, lane);
            } else {
                tr_matrix(IN(10) + (size_t)sub * DM * ODD_IN, ODD_IN, DM, 0, ODD_IN, WINT, 0, scr, gw, NGW, lane);
                tr_matrix(IN(19) + (size_t)sub * 1024 * 1024, 1024, 1024, 0, 1024, WGLUT, 0, scr, gw, NGW, lane);
                tr_matrix(IN(21) + (size_t)sub * DM * DM, DM, DM, 0, DM, WOUTT, 0, scr, gw, NGW, lane);
            }
            tr_matrix(IN(22) + (size_t)layer * DM * XAW, XAW, DM, 0, XAW, WQT, 0, scr, gw, NGW, lane);
            tr_matrix(IN(24) + (size_t)layer * XAW * DM, DM, XAW, 0, DM, WOT, 0, scr, gw, NGW, lane);
            tr_matrix(IN(25) + (size_t)layer * DM * DFF, DFF, DM, 0, DFF, W1T, 0, scr, gw, NGW, lane);
            tr_matrix(IN(26) + (size_t)layer * DFF * DM, DM, DFF, 0, DM, W2T, 0, scr, gw, NGW, lane);
            rms_rows((layer == 0) ? x_in : H, IN(2) + layer * DM, XN, nullptr, NT, gw, NGW, lane);
        PH_END
        PH_BEGIN
            if (even) { pg8::EpiBf E{PROJ, EVEN_LD, 0, FLOG, 28}; run_gemm(lds, XN, WINT, NT, EVEN_N, DM, E); }
#ifdef DBG_TWICE
            if (layer == 2) { pg8::EpiBf E2{MIX, DM, 0, nullptr, -1}; run_gemm(lds, XN, WINT, NT, DM, DM, E2); }
#endif
            else { pg8::EpiBf E{PROJ, ODD_IN, 0, nullptr, -1}; run_gemm(lds, XN, WINT, NT, ODD_IN, DM, E); }
            if (layer == 0) { pg8::EpiBf E{KVX, 4096, 0, nullptr, -1}; run_gemm(lds, MEMN, WKVT, NB * MEML, 4096, DM, E); }
        PH_END
        if (even) {
            PH_BEGIN
                if (bid < 32) {
                    const int b = bid >> 3, h = bid & 7; const float bias = IN(8)[sub * 8 + h];
                    float v[8]; float run = 0.f;
#pragma unroll
                    for (int e = 0; e < 8; ++e) { const float xx = FLOG[(size_t)(b * SEQ + tid * 8 + e) * 8 + h] + bias;
                        const float ls = fminf(xx, 0.f) - log1pf(__expf(-fabsf(xx))); run += ls; v[e] = run; }
                    float inc = run;
#pragma unroll
                    for (int o = 1; o < 64; o <<= 1) { const float t = __shfl_up(inc, o); if (lane >= o) inc += t; }
                    LAS float* wsum = (LAS float*)(lds + 131072);
                    __syncthreads();
                    if (lane == 63) wsum[wave] = inc;
                    __syncthreads();
                    float off = inc - run;
                    for (int j = 0; j < wave; ++j) off += wsum[j];
#pragma unroll
                    for (int e = 0; e < 8; ++e) C2[(size_t)(b * 8 + h) * SEQ + tid * 8 + e] = (v[e] + off) * LOG2E;
                }
                for (int t = gw; t < NT; t += NGW) { const int pos = t & (SEQ - 1), slot = lane >> 2, i0 = (lane & 3) * 16;
                    bf16* p1 = PROJ + (size_t)t * EVEN_LD + 3072 + slot * 128 + i0; bf16* p2 = p1 + 64;
                    const float sc = (slot >= 8) ? QK_SCALE : 1.f;
#pragma unroll
                    for (int hlf = 0; hlf < 2; ++hlf) { const u32x4 a = *(const u32x4*)(p1 + hlf * 8), c = *(const u32x4*)(p2 + hlf * 8); u32x4 o1, o2;
#pragma unroll
                        for (int e = 0; e < 4; ++e) { const int ii = i0 + hlf * 8 + 2 * e;
                            const float c0 = ROPE[pos * 64 + ii], c1 = ROPE[pos * 64 + ii + 1], s0 = ROPE[SEQ * 64 + pos * 64 + ii], s1 = ROPE[SEQ * 64 + pos * 64 + ii + 1];
                            const float a0 = bflo(a[e]), a1 = bfhi(a[e]), b0 = bflo(c[e]), b1 = bfhi(c[e]);
                            o1[e] = pk2((a0 * c0 - b0 * s0) * sc, (a1 * c1 - b1 * s1) * sc); o2[e] = pk2((a0 * s0 + b0 * c0) * sc, (a1 * s1 + b1 * c1) * sc); }
                        *(u32x4*)(p1 + hlf * 8) = o1; *(u32x4*)(p2 + hlf * 8) = o2; } }
                { LAS unsigned char* scr = lds + wave * 9216;
                  for (int it = gw; it < NB * 16 * 64 * 2; it += NGW) { const int dh = it & 1, tb = (it >> 1) & 63, h16 = (it >> 7) & 15, b = it >> 11;
                      const bf16* src = PROJ + (size_t)(b * SEQ + tb * 64) * EVEN_LD + (h16 < 8 ? 2048 + h16 * 128 : 5120 + (h16 - 8) * 128) + dh * 64;
                      bf16* dst = VT + ((size_t)(b * 16 + h16) * 128 + dh * 64) * SEQ + tb * 64;
                      tr_bf16_64x64(src, EVEN_LD, dst, SEQ, scr, lane); }
                  if (layer == 0) for (int it = gw; it < DEPTH * NB * 4 * 4 * 2; it += NGW) { const int dh = it & 1, kb = (it >> 1) & 3, h = (it >> 3) & 3, b = (it >> 5) & 3, l = it >> 7;
                      const bf16* src = KVX + (size_t)(b * MEML + kb * 64) * 4096 + l * 1024 + 512 + h * 128 + dh * 64;
                      bf16* dst = VTX + ((size_t)((l * NB + b) * 4 + h) * 128 + dh * 64) * MEML + kb * 64;
                      tr_bf16_64x64(src, 4096, dst, MEML, scr, lane); } }
            PH_END
            PH_BEGIN
                const int NU = NB * 16 * 16;
                for (int r = 0; r * G < NU; ++r) { const int sidx = r * G + ((r & 1) ? (G - 1 - bid) : bid); if (sidx >= NU) continue;
                    const int qb = 15 - (sidx >> 6), bh = sidx & 63, b = bh >> 4, h16 = bh & 15, h = h16 & 7;
                    const bf16* rowb = PROJ + (size_t)(b * SEQ) * EVEN_LD; const bf16* vt = VT + (size_t)(b * 16 + h16) * 128 * SEQ; bf16* ob = MIX + (size_t)(b * SEQ) * DM;
#ifndef NO_ATTN
                    if (h16 < 8) attn_unit<0>(lds, rowb + h * 128, EVEN_LD, rowb + 1024 + h * 128, EVEN_LD, vt, SEQ, ob + h * 128, DM, qb * 256, 0, C2 + (size_t)(b * 8 + h) * SEQ, 0.f, nullptr);
                    else { const float l2g = log2f(1.f - exp2f(-5.f - (float)h));
                        attn_unit<1>(lds, rowb + 3072 + h * 128, EVEN_LD, rowb + 4096 + h * 128, EVEN_LD, vt, SEQ, ob + 1024 + h * 128, DM, qb * 256, 0, nullptr, l2g, rowb + 6144 + h * 128); }
#endif
                }
            PH_END
        } else {
            PH_BEGIN
                S5P P{IN(11) + sub * 4096, IN(12) + sub * 4096, IN(13) + (size_t)sub * 65536, IN(14) + (size_t)sub * 65536,
                      IN(15) + (size_t)sub * 65536, IN(16) + (size_t)sub * 65536, IN(17) + sub * 1024, IN(18) + sub * 4096};
#ifndef NO_S5
                for (int u = bid; u < NB * 64; u += G) s5_unit(lds, u >> 6, u & 63, PROJ, GB, P);
#endif
                const float* cw = IN(20) + sub * 3 * 1024;
                for (int idx = bid * 512 + tid; idx < NT * 128; idx += G * 512) { const int tok = idx >> 7, ch = (idx & 127) * 8, l = tok & (SEQ - 1);
                    const bf16* row = PROJ + (size_t)tok * ODD_IN;
                    float acc[8];
#pragma unroll
                    for (int e = 0; e < 8; ++e) acc[e] = 0.f;
#pragma unroll
                    for (int k = 0; k < 3; ++k) { const int back = 2 - k; if (l - back < 0) continue;
                        const u32x4 hv = *(const u32x4*)(row - (size_t)back * ODD_IN + 1024 + ch), gc = *(const u32x4*)(row - (size_t)back * ODD_IN + 3072 + ch);
                        const f32x4 w0 = *(const f32x4*)(cw + k * 1024 + ch), w1 = *(const f32x4*)(cw + k * 1024 + ch + 4);
#pragma unroll
                        for (int e = 0; e < 4; ++e) { const float wa = (e < 2) ? w0[2 * e] : w1[2 * e - 4], wb = (e < 2) ? w0[2 * e + 1] : w1[2 * e - 3];
                            acc[2 * e] += wa * (bflo(hv[e]) * bflo(gc[e])); acc[2 * e + 1] += wb * (bfhi(hv[e]) * bfhi(gc[e])); } }
                    const u32x4 gb = *(const u32x4*)(row + 2048 + ch); u32x4 o;
#pragma unroll
                    for (int e = 0; e < 4; ++e) o[e] = pk2(bflo(gb[e]) * acc[2 * e], bfhi(gb[e]) * acc[2 * e + 1]);
                    *(u32x4*)(MIX + (size_t)tok * DM + 1024 + ch) = o; }
            PH_END
            PH_BEGIN
                pg8::EpiGlu E{GB, 1024, MIX, DM}; run_gemm(lds, GB, WGLUT, NT, 1024, 1024, E);
            PH_END
        }
        PH_BEGIN
            pg8::EpiResid E{(layer == 0) ? x_in : H, H, DM}; run_gemm(lds, MIX, WOUTT, NT, DM, DM, E);
        PH_END
        PH_BEGIN
            rms_rows(H, IN(3) + layer * DM, XN, nullptr, NT, gw, NGW, lane);
        PH_END
        PH_BEGIN
            pg8::EpiBf E{QX, XAW, 0, nullptr, -1}; run_gemm(lds, XN, WQT, NT, XAW, DM, E);
        PH_END
        PH_BEGIN
            for (int u = bid; u < NB * 4 * 16; u += G) { const int qb = u & 15, h = (u >> 4) & 3, b = u >> 6;
#ifndef NO_XATTN
                attn_unit<2>(lds, QX + (size_t)(b * SEQ) * XAW + h * 128, XAW, KVX + (size_t)(b * MEML) * 4096 + layer * 1024 + h * 128, 4096,
                             VTX + (size_t)((layer * NB + b) * 4 + h) * 128 * MEML, MEML, XO + (size_t)(b * SEQ) * XAW + h * 128, XAW, qb * 256, MEML, nullptr, 0.f, nullptr);
#endif
            }
        PH_END
        PH_BEGIN
            pg8::EpiResid E{H, H, DM}; run_gemm(lds, XO, WOT, NT, DM, XAW, E);
        PH_END
        PH_BEGIN
            rms_rows(H, IN(4) + layer * DM, XN, nullptr, NT, gw, NGW, lane);
        PH_END
        PH_BEGIN
#ifndef DBG_SKIPMLP
            pg8::EpiBf E{PROJ, DFF, 1, nullptr, -1}; run_gemm(lds, XN, W1T, NT, DFF, DM, E);
#endif
        PH_END
        PH_BEGIN
#ifndef DBG_SKIPMLP
            pg8::EpiResid E{H, H, DM}; run_gemm(lds, PROJ, W2T, NT, DM, DFF, E);
#endif
        PH_END
    }
    PH_BEGIN
#ifdef DBG_OUTBUF
        { const bf16* src = (const bf16*)(ws + DBG_OUTBUF); for (size_t i = (size_t)bid * 512 + tid; i < (size_t)NT * DM; i += (size_t)G * 512) { const size_t t = i >> 11, c = i & 2047; float v = __uint_as_float((unsigned)src[t * DBG_OUTLD + DBG_OUTCOL + c] << 16);
#ifdef DBG_TWICE
            v -= __uint_as_float((unsigned)MIX[t * DM + c] << 16);
#endif
            args.out[i] = v; } }
#else
        rms_rows(H, IN(6), nullptr, args.out, NT, gw, NGW, lane);
#endif
    PH_END
#undef PH_BEGIN
#undef PH_END
}
#undef H
#undef XN
#undef PROJ
#undef MIX
#undef VT
#undef GB
#undef QX
#undef XO
#undef IN
#undef x_in

extern "C" void kernel_launch(void* const* d_in, const int* in_sizes, int n_in, void* d_out, int out_size, void* d_ws, size_t ws_size, hipStream_t stream) {
    static int grid = 0;
    if (grid == 0) {
        if (n_in != 27 || out_size != NT * DM || ws_size < WS_END) { fprintf(stderr, "kernel_launch: unexpected problem (n_in %d out %d ws %zu, need %zu)\n", n_in, out_size, ws_size, (size_t)WS_END); grid = -1; return; }
        int dev = 0, cus = 0, per_cu = 0;
        hipGetDevice(&dev); hipDeviceGetAttribute(&cus, hipDeviceAttributeMultiprocessorCount, dev);
        if (hipFuncSetAttribute((const void*)trunk_fwd, hipFuncAttributeMaxDynamicSharedMemorySize, LDS_BYTES) != hipSuccess) { fprintf(stderr, "kernel_launch: hipFuncSetAttribute failed\n"); grid = -1; return; }
        hipOccupancyMaxActiveBlocksPerMultiprocessor(&per_cu, (const void*)trunk_fwd, 512, LDS_BYTES);
        if (per_cu < 1) { fprintf(stderr, "kernel_launch: occupancy query says %d blocks/CU\n", per_cu); per_cu = 1; }
        (void)hipGetLastError();
        grid = cus * 1;
    }
    if (grid < 0) return;
    (void)hipMemsetAsync(d_ws, 0, 256, stream);
    Args a{};
    for (int i = 0; i < 27; ++i) a.in[i] = (const float*)d_in[i];
    a.out = (float*)d_out; a.ws = (unsigned char*)d_ws;
#if MK_ONE_LAUNCH
    a.ph_lo = 0; a.ph_hi = N_PHASES;
    { void* kargs[] = {&a}; hipError_t e = hipLaunchCooperativeKernel((const void*)trunk_fwd, dim3(grid), dim3(512), kargs, LDS_BYTES, stream);
      if (e != hipSuccess) fprintf(stderr, "cooperative launch failed: %s (grid %d)\n", hipGetErrorString(e), grid); }
#else
    for (int p = 0; p < N_PHASES; ++p) { a.ph_lo = p; a.ph_hi = p + 1;
        void* kargs[] = {&a}; hipError_t e = hipLaunchCooperativeKernel((const void*)trunk_fwd, dim3(grid), dim3(512), kargs, LDS_BYTES, stream);
        if (e != hipSuccess) { fprintf(stderr, "launch %d failed: %s (grid %d)\n", p, hipGetErrorString(e), grid); break; } }
#endif
}
```

```cpp
#include <hip/hip_runtime.h>
#include <hip/hip_cooperative_groups.h>
#include <cstdio>
#include <cstdint>
namespace cg = cooperative_groups;
#ifndef PG8_AUX
#define PG8_AUX 0
#endif
namespace pg8 {
#define PG8_LAS __attribute__((address_space(3)))
typedef unsigned short bf16_t;
typedef short bf16x8 __attribute__((ext_vector_type(8)));
typedef float f32x4 __attribute__((ext_vector_type(4)));
typedef unsigned u32x4 __attribute__((ext_vector_type(4)));
constexpr int BM = 256, BK = 64, HALF = 128, HTB = HALF * BK * 2  , STAGE_BYTES = 8 * HTB, NXCD = 8, WGM = 8;

__host__ __device__ __forceinline__ int lds_byte(int r, int c) { const int st = (r >> 4) * 2 + (c >> 5), rr = r & 15, cc = c & 31, ob = rr * 64 + cc * 2; return st * 1024 + (ob ^ (((ob >> 9) & 1) << 5)); }
__host__ __device__ __forceinline__ void stage_rc(int b, int& R, int& C) { const int st = b / 1024, sb = b % 1024, swz = sb ^ (((sb >> 9) & 1) << 5); R = (st >> 1) * 16 + swz / 64; C = (st & 1) * 32 + (swz % 64) / 2; }
__host__ __device__ __forceinline__ int perm32(int rho) { const int n = rho >> 4, i = rho & 15; return 8 * (i >> 2) + 4 * n + (i & 3); }

struct Unit { int pm, pn; };
struct Gemm { const bf16_t* A; const bf16_t* Bt; int M, N, K, ld; };

struct StaticOrder {
    int nM, nN, nwg, G, c;
    __host__ __device__ void init(int M, int N, int G_, int c_) { nM = M / BM; nN = N / BM; nwg = nM * nN; G = G_; c = c_; }
    __host__ __device__ bool next(int i, Unit& u) const {
        const long L = (long)i * G + c; if (L >= nwg) return false;
        int wgid = (int)L; { const int q = nwg / NXCD, r = nwg % NXCD, xcd = wgid % NXCD, off = wgid / NXCD; wgid = (xcd < r ? xcd * (q + 1) : r * (q + 1) + (xcd - r) * q) + off; }
        const int nig = WGM * nN, gid = wgid / nig, fm = gid * WGM, gsz = (nM - fm) < WGM ? (nM - fm) : WGM;
        u.pm = fm + ((wgid % nig) % gsz); u.pn = (wgid % nig) / gsz; return true;
    }
    __device__ __forceinline__ void a_ready(const Unit&) const {}
    __device__ __forceinline__ void done(const Unit&) const {}
};

__device__ __forceinline__ unsigned cvt_pk_bf16(float lo, float hi) { unsigned r; asm volatile("v_cvt_pk_bf16_f32 %0, %1, %2" : "=v"(r) : "v"(lo), "v"(hi)); return r; }
struct EpiBf {
    static constexpr bool PERM = true, AFTER_DRAIN = false;
    bf16_t* O; int ldc; int act; float* flog; int flog_tile;
    __device__ __forceinline__ void operator()(const f32x4 (&acc)[2][2][4][2], const Unit& u, int wr, int wc, int fr, int fq) const {
        const int row0 = u.pm * BM + wr * 64 + fr;
        if (u.pn == flog_tile) {
            if (wc == 0 && fq == 0) {
#pragma unroll
                for (int ai = 0; ai < 2; ++ai)
#pragma unroll
                    for (int m = 0; m < 4; ++m) { float* p = flog + (size_t)(row0 + ai * HALF + m * 16) * 8; *(f32x4*)p = acc[ai][0][m][0]; *(f32x4*)(p + 4) = acc[ai][0][m][1]; }
            }
            return;
        }
        const int col0 = u.pn * BM + wc * 32 + 8 * fq;
#pragma unroll
        for (int ai = 0; ai < 2; ++ai)
#pragma unroll
            for (int m = 0; m < 4; ++m) { bf16_t* rowp = O + (size_t)(row0 + ai * HALF + m * 16) * ldc + col0;
#pragma unroll
                for (int bj = 0; bj < 2; ++bj) { f32x4 v0 = acc[ai][bj][m][0], v1 = acc[ai][bj][m][1];
                    if (act) {
#pragma unroll
                        for (int e = 0; e < 4; ++e) { float a = fmaxf(v0[e], 0.f), b = fmaxf(v1[e], 0.f); v0[e] = a * a; v1[e] = b * b; } }
                    u32x4 w; w.x = cvt_pk_bf16(v0[0], v0[1]); w.y = cvt_pk_bf16(v0[2], v0[3]); w.z = cvt_pk_bf16(v1[0], v1[1]); w.w = cvt_pk_bf16(v1[2], v1[3]);
                    *(u32x4*)(rowp + bj * HALF) = w; } }
    }
};
struct EpiResid {
    static constexpr bool PERM = false, AFTER_DRAIN = false;
    const float* base; float* out; int ldc;
    __device__ __forceinline__ void operator()(const f32x4 (&acc)[2][2][4][2], const Unit& u, int wr, int wc, int fr, int fq) const {
        const int col0 = u.pn * BM + wc * 32 + 4 * fq;
#pragma unroll
        for (int ai = 0; ai < 2; ++ai)
#pragma unroll
            for (int m = 0; m < 4; ++m) { const size_t off = (size_t)(u.pm * BM + ai * HALF + wr * 64 + m * 16 + fr) * ldc + col0;
#pragma unroll
                for (int bj = 0; bj < 2; ++bj)
#pragma unroll
                    for (int n = 0; n < 2; ++n) { const f32x4 bs = *(const f32x4*)(base + off + bj * HALF + n * 16); *(f32x4*)(out + off + bj * HALF + n * 16) = bs + acc[ai][bj][m][n]; }
                asm volatile("" ::: "memory"); }
    }
};
struct EpiGlu {
    static constexpr bool PERM = true, AFTER_DRAIN = false;
    const bf16_t* Gm; int ldg; bf16_t* O; int ldc;
    __device__ __forceinline__ void operator()(const f32x4 (&acc)[2][2][4][2], const Unit& u, int wr, int wc, int fr, int fq) const {
        const int row0 = u.pm * BM + wr * 64 + fr, col0 = u.pn * BM + wc * 32 + 8 * fq;
#pragma unroll
        for (int ai = 0; ai < 2; ++ai)
#pragma unroll
            for (int m = 0; m < 4; ++m) { const size_t r = (size_t)(row0 + ai * HALF + m * 16);
#pragma unroll
                for (int bj = 0; bj < 2; ++bj) { const u32x4 gv = *(const u32x4*)(Gm + r * ldg + col0 + bj * HALF);
                    const f32x4 v0 = acc[ai][bj][m][0], v1 = acc[ai][bj][m][1]; float o[8];
#pragma unroll
                    for (int e = 0; e < 4; ++e) { const unsigned w = gv[e]; const float g0 = __uint_as_float(w << 16), g1 = __uint_as_float(w & 0xffff0000u);
                        const float a0 = (e < 2) ? v0[2 * e] : v1[2 * e - 4], a1 = (e < 2) ? v0[2 * e + 1] : v1[2 * e - 3];
                        o[2 * e] = g0 / (1.f + __expf(-a0)); o[2 * e + 1] = g1 / (1.f + __expf(-a1)); }
                    u32x4 w; w.x = cvt_pk_bf16(o[0], o[1]); w.y = cvt_pk_bf16(o[2], o[3]); w.z = cvt_pk_bf16(o[4], o[5]); w.w = cvt_pk_bf16(o[6], o[7]);
                    *(u32x4*)(O + r * ldc + col0 + bj * HALF) = w; }
                asm volatile("" ::: "memory"); }
    }
};
template <class Epi, class Sched, bool ALIGN_EPI = false, bool SP2 = false>
__device__ __forceinline__ void gemm_phase(PG8_LAS unsigned char* lds, const Gemm g, const Sched& S, const Epi& E) {
    int tid_ = threadIdx.x; asm volatile("" : "+v"(tid_));
    const int tid = tid_, wid = __builtin_amdgcn_readfirstlane(tid >> 6), lane = tid & 63, wr = wid >> 2, wc = wid & 3, fr = lane & 15, fq = lane >> 4;
    const int K = g.K, nt = K / BK, LD = g.ld;
    unsigned voffA[2], voffB[2];
#pragma unroll
    for (int i = 0; i < 2; ++i) { int R, C; stage_rc(tid * 16 + i * 8192, R, C); const int Rb = Epi::PERM ? ((R & ~31) + perm32(R & 31)) : R;
        voffA[i] = (unsigned)(R * LD + C) * 2u; voffB[i] = (unsigned)(Rb * LD + C) * 2u; }
    const size_t kstep = (size_t)(BK * 2);
    const size_t hstep = (size_t)HALF * LD * 2;
    const size_t tstep = 2 * hstep;
    const unsigned ldsw = (unsigned)wid * 1024u;
    const int aoff = lds_byte(wr * 64 + fr, fq * 8), boff = lds_byte(wc * 32 + fr, fq * 8);
#define PG8_SA(b, h) (((b) * 2 + (h)) * HTB)
#define PG8_SB(b, h) ((4 + (b) * 2 + (h)) * HTB)
#define PG8_STAGE(bufoff, gbase, voff) do { _Pragma("unroll") for (int _i = 0; _i < 2; ++_i) \
        __builtin_amdgcn_global_load_lds((const unsigned*)((const char*)(gbase) + (voff)[_i]), (PG8_LAS unsigned*)(lds + (bufoff) + ldsw + _i * 8192), 16, 0, PG8_AUX); } while (0)
#define PG8_LDA(dst, b, h) do { _Pragma("unroll") for (int m = 0; m < 4; ++m) _Pragma("unroll") for (int k = 0; k < 2; ++k) dst[m][k] = *(const PG8_LAS bf16x8*)(lds + PG8_SA(b, h) + aoff + m * 2048 + k * 1024); } while (0)
#define PG8_LDB(dst, b, h) do { _Pragma("unroll") for (int n = 0; n < 2; ++n) _Pragma("unroll") for (int k = 0; k < 2; ++k) dst[n][k] = *(const PG8_LAS bf16x8*)(lds + PG8_SB(b, h) + boff + n * 2048 + k * 1024); } while (0)
#define PG8_MMA(ai, bj, At, Bt) do { __builtin_amdgcn_s_setprio(1); _Pragma("unroll") for (int m = 0; m < 4; ++m) _Pragma("unroll") for (int n = 0; n < 2; ++n) _Pragma("unroll") for (int k = 0; k < 2; ++k) \
        acc[ai][bj][m][n] = __builtin_amdgcn_mfma_f32_16x16x32_bf16(Bt[n][k], At[m][k], acc[ai][bj][m][n], 0, 0, 0); __builtin_amdgcn_s_setprio(0); } while (0)
#ifdef DBG_DRAIN
#define PG8_WAIT_V(n) asm volatile("s_waitcnt vmcnt(0)" ::: "memory")
#else
#define PG8_WAIT_V(n) asm volatile("s_waitcnt vmcnt(" #n ")" ::: "memory")
#endif
#define PG8_WAIT_L(n) asm volatile("s_waitcnt lgkmcnt(" #n ")" ::: "memory")
#define PG8_BAR __builtin_amdgcn_s_barrier()
#define PG8_SCHED __builtin_amdgcn_sched_barrier(0)
    Unit cur, nxt; int ui = 0;
    if (!S.next(0, cur)) return;
    f32x4 acc[2][2][4][2];
#pragma unroll
    for (int a = 0; a < 2; ++a)
#pragma unroll
        for (int b = 0; b < 2; ++b)
#pragma unroll
            for (int m = 0; m < 4; ++m)
#pragma unroll
                for (int n = 0; n < 2; ++n) acc[a][b][m][n] = (f32x4){0.f, 0.f, 0.f, 0.f};
    bf16x8 At[4][2], B0[2][2], B1[2][2];
    const char* cA = (const char*)g.A + (size_t)cur.pm * tstep; const char* cB = (const char*)g.Bt + (size_t)cur.pn * tstep;
    S.a_ready(cur);
    if constexpr (SP2) {
        PG8_STAGE(PG8_SB(0, 0), cB, voffB); PG8_STAGE(PG8_SB(0, 1), cB + hstep, voffB); PG8_STAGE(PG8_SA(0, 0), cA, voffA); PG8_STAGE(PG8_SA(0, 1), cA + hstep, voffA);
        if (wr == 1) PG8_BAR;
        PG8_WAIT_V(2); PG8_BAR;
        PG8_STAGE(PG8_SB(1, 0), cB + kstep, voffB); PG8_STAGE(PG8_SA(1, 0), cA + kstep, voffA); PG8_STAGE(PG8_SB(1, 1), cB + hstep + kstep, voffB);
        PG8_WAIT_V(6); PG8_BAR;
    } else {
        PG8_STAGE(PG8_SB(0, 0), cB, voffB); PG8_STAGE(PG8_SA(0, 0), cA, voffA); PG8_STAGE(PG8_SB(0, 1), cB + hstep, voffB); PG8_STAGE(PG8_SA(0, 1), cA + hstep, voffA);
        if (wr == 1) PG8_BAR;
        PG8_WAIT_V(4); PG8_BAR;
        PG8_STAGE(PG8_SB(1, 0), cB + kstep, voffB); PG8_STAGE(PG8_SA(1, 0), cA + kstep, voffA); PG8_STAGE(PG8_SB(1, 1), cB + hstep + kstep, voffB);
        PG8_WAIT_V(6); PG8_BAR;
    }
    for (;;) {
        const bool has_next = S.next(ui + 1, nxt);
        const char* nA = has_next ? (const char*)g.A + (size_t)nxt.pm * tstep : cA; const char* nB = has_next ? (const char*)g.Bt + (size_t)nxt.pn * tstep : cB;
        for (int t = 0; t < nt; t += 2) {
            const bool last = (t == nt - 2);
            const char* a1 = cA + (size_t)(t + 1) * kstep;
            const char* a2 = last ? nA : cA + (size_t)(t + 2) * kstep; const char* b2 = last ? nB : cB + (size_t)(t + 2) * kstep;
            const char* a3 = a2 + kstep; const char* b3 = b2 + kstep;
            if (last && has_next) S.a_ready(nxt);
            if constexpr (SP2) {
            PG8_LDB(B0, 0, 0); PG8_LDB(B1, 0, 1); PG8_SCHED; PG8_LDA(At, 0, 0); PG8_STAGE(PG8_SA(1, 1), a1 + hstep, voffA);
            PG8_WAIT_V(8); PG8_WAIT_L(0); PG8_BAR; PG8_MMA(0, 0, At, B0); PG8_MMA(0, 1, At, B1); PG8_BAR; PG8_SCHED;
            PG8_LDA(At, 0, 1); PG8_STAGE(PG8_SB(0, 0), b2, voffB); PG8_STAGE(PG8_SB(0, 1), b2 + hstep, voffB); PG8_STAGE(PG8_SA(0, 0), a2, voffA);
            PG8_WAIT_V(8); PG8_WAIT_L(0); PG8_BAR; PG8_MMA(1, 0, At, B0); PG8_MMA(1, 1, At, B1); PG8_BAR; PG8_SCHED;
            PG8_LDB(B0, 1, 0); PG8_LDB(B1, 1, 1); PG8_SCHED; PG8_LDA(At, 1, 0); PG8_STAGE(PG8_SA(0, 1), a2 + hstep, voffA);
            PG8_WAIT_V(8); PG8_WAIT_L(0); PG8_BAR; PG8_MMA(0, 0, At, B0); PG8_MMA(0, 1, At, B1); PG8_BAR; PG8_SCHED;
            PG8_LDA(At, 1, 1); PG8_STAGE(PG8_SB(1, 0), b3, voffB); PG8_STAGE(PG8_SB(1, 1), b3 + hstep, voffB); PG8_STAGE(PG8_SA(1, 0), a3, voffA);
            PG8_WAIT_V(8); PG8_WAIT_L(0); PG8_BAR; PG8_MMA(1, 0, At, B0); PG8_MMA(1, 1, At, B1); PG8_BAR; PG8_SCHED;
            } else {
            PG8_LDB(B0, 0, 0); PG8_SCHED; PG8_LDA(At, 0, 0); PG8_STAGE(PG8_SA(1, 1), a1 + hstep, voffA);
            PG8_WAIT_L(8); PG8_BAR; PG8_WAIT_L(0); PG8_MMA(0, 0, At, B0); PG8_BAR; PG8_SCHED;
            PG8_LDB(B1, 0, 1); PG8_STAGE(PG8_SB(0, 0), b2, voffB);
            PG8_BAR; PG8_WAIT_L(0); PG8_MMA(0, 1, At, B1); PG8_BAR;
            PG8_LDA(At, 0, 1); PG8_STAGE(PG8_SA(0, 0), a2, voffA);
            PG8_BAR; PG8_WAIT_L(0); PG8_MMA(1, 0, At, B0); PG8_BAR; PG8_SCHED;
            PG8_STAGE(PG8_SB(0, 1), b2 + hstep, voffB);
            PG8_WAIT_V(6); PG8_BAR; PG8_MMA(1, 1, At, B1); PG8_BAR;
            PG8_LDB(B0, 1, 0); PG8_SCHED; PG8_LDA(At, 1, 0); PG8_STAGE(PG8_SA(0, 1), a2 + hstep, voffA);
            PG8_WAIT_L(8); PG8_BAR; PG8_WAIT_L(0); PG8_MMA(0, 0, At, B0); PG8_BAR; PG8_SCHED;
            PG8_LDB(B1, 1, 1); PG8_STAGE(PG8_SB(1, 0), b3, voffB);
            PG8_BAR; PG8_WAIT_L(0); PG8_MMA(0, 1, At, B1); PG8_BAR;
            PG8_LDA(At, 1, 1); PG8_STAGE(PG8_SA(1, 0), a3, voffA);
            PG8_BAR; PG8_WAIT_L(0); PG8_MMA(1, 0, At, B0); PG8_BAR; PG8_SCHED;
            PG8_STAGE(PG8_SB(1, 1), b3 + hstep, voffB);
            PG8_WAIT_V(6); PG8_BAR; PG8_MMA(1, 1, At, B1); PG8_BAR;
            }
        }
        if constexpr (ALIGN_EPI) { if (wr == 0) PG8_BAR; }
        if constexpr (!Epi::AFTER_DRAIN) { E(acc, cur, wr, wc, fr, fq); S.done(cur); }
        if (!has_next) break;
#pragma unroll
        for (int a = 0; a < 2; ++a)
#pragma unroll
            for (int b = 0; b < 2; ++b)
#pragma unroll
                for (int m = 0; m < 4; ++m)
#pragma unroll
                    for (int n = 0; n < 2; ++n) acc[a][b][m][n] = (f32x4){0.f, 0.f, 0.f, 0.f};
        cur = nxt; cA = nA; cB = nB; ++ui;
        if constexpr (ALIGN_EPI) { if (wr == 1) PG8_BAR; }
    }
    PG8_WAIT_V(0);
    if constexpr (!ALIGN_EPI) { if (wr == 0) PG8_BAR; }
    PG8_BAR;
    if constexpr (Epi::AFTER_DRAIN) { E.fused(acc, cur, wr, wc, fr, fq, lds, wid, lane); S.done(cur); }
#undef PG8_SA
#undef PG8_SB
#undef PG8_STAGE
#undef PG8_LDA
#undef PG8_LDB
#undef PG8_MMA
#undef PG8_WAIT_V
#undef PG8_WAIT_L
#undef PG8_BAR
#undef PG8_SCHED
}
}
#ifndef MK_ONE_LAUNCH
#define MK_ONE_LAUNCH 1
#endif
#define LAS __attribute__((address_space(3)))
typedef unsigned short bf16;
typedef short bf16x8 __attribute__((ext_vector_type(8)));
typedef short bf16x4 __attribute__((ext_vector_type(4)));
typedef float f32x4 __attribute__((ext_vector_type(4)));
typedef unsigned u32x4 __attribute__((ext_vector_type(4)));
typedef unsigned u32x2 __attribute__((ext_vector_type(2)));

constexpr int NB = 4, SEQ = 4096, DM = 2048, NT = NB * SEQ, DEPTH = 4;
constexpr int EVEN_IN = 7176, EVEN_N = 7168, EVEN_LD = 7168, ODD_IN = 4096, DFF = 8192, XAW = 512, MEML = 256;
constexpr float EPS = 1e-6f;
constexpr float LOG2E = 1.4426950408889634f;
constexpr float QK_SCALE = 0.08838834764831845f;

constexpr size_t MiB = 1u << 20;
constexpr size_t WS_H = 1 * MiB;
constexpr size_t WS_XN = WS_H + 128 * MiB;
constexpr size_t WS_PROJ = WS_XN + 64 * MiB;
constexpr size_t WS_MIX = WS_PROJ + 256 * MiB;
constexpr size_t WS_VT = WS_MIX + 64 * MiB;
constexpr size_t WS_QX = WS_VT + 64 * MiB;
constexpr size_t WS_XO = WS_QX + 16 * MiB;
constexpr size_t WS_FLOG = WS_XO + 16 * MiB;
constexpr size_t WS_C2 = WS_FLOG + 1 * MiB;
constexpr size_t WS_MEMN = WS_C2 + 1 * MiB;
constexpr size_t WS_KVX = WS_MEMN + 4 * MiB;
constexpr size_t WS_VTX = WS_KVX + 8 * MiB;
constexpr size_t WS_ROPE = WS_VTX + 4 * MiB;
constexpr size_t WS_WKVT = WS_ROPE + 2 * MiB;
constexpr size_t WS_WINT = WS_WKVT + 16 * MiB;
constexpr size_t WS_WOUTT = WS_WINT + 30 * MiB;
constexpr size_t WS_WQT = WS_WOUTT + 8 * MiB;
constexpr size_t WS_WOT = WS_WQT + 2 * MiB;
constexpr size_t WS_W1T = WS_WOT + 2 * MiB;
constexpr size_t WS_W2T = WS_W1T + 32 * MiB;
constexpr size_t WS_WGLUT = WS_W2T + 32 * MiB;
constexpr size_t WS_END = WS_WGLUT + 2 * MiB;

constexpr int LDS_BYTES = 147456;

__device__ __forceinline__ unsigned f2bf(float f) { unsigned u = __builtin_bit_cast(unsigned, f); return (u + 0x7fffu + ((u >> 16) & 1u)) >> 16; }
__device__ __forceinline__ unsigned pk2(float lo, float hi) { unsigned r; asm("v_cvt_pk_bf16_f32 %0, %1, %2" : "=v"(r) : "v"(lo), "v"(hi)); return r; }
__device__ __forceinline__ float bflo(unsigned w) { return __uint_as_float(w << 16); }
__device__ __forceinline__ float bfhi(unsigned w) { return __uint_as_float(w & 0xffff0000u); }
__device__ __forceinline__ float wave_sum(float v) {
#pragma unroll
    for (int o = 1; o < 64; o <<= 1) v += __shfl_xor(v, o);
    return v;
}
#define LDS_FENCE() do { asm volatile("s_waitcnt lgkmcnt(0)" ::: "memory"); __builtin_amdgcn_wave_barrier(); } while (0)

struct Args { const float* in[27]; float* out; unsigned char* ws; int ph_lo, ph_hi; };

__device__ __forceinline__ void tr_load(f32x4 (&v)[8], const float* __restrict__ W, int ldw, int col0, int k0, int lane) {
#pragma unroll
    for (int i = 0; i < 8; ++i) v[i] = __builtin_nontemporal_load((const f32x4*)(W + (size_t)(k0 + i * 8 + (lane >> 3)) * ldw + col0 + 4 * (lane & 7)));
}
__device__ __forceinline__ void tr_store(const f32x4 (&v)[8], int K, bf16* __restrict__ WT, int drow0, int k0, LAS float* scr, int lane) {
    const int c4 = lane & 7, r8 = lane >> 3;
#pragma unroll
    for (int i = 0; i < 8; ++i) { LAS float* d = scr + (i * 8 + r8) * 33 + 4 * c4; d[0] = v[i].x; d[1] = v[i].y; d[2] = v[i].z; d[3] = v[i].w; }
    LDS_FENCE();
    const int c = lane & 7;
#pragma unroll
    for (int j = 0; j < 4; ++j) { const int n = (lane >> 3) + 8 * j; const LAS float* s = scr + (8 * c) * 33 + n;
        u32x4 o; o.x = pk2(s[0 * 33], s[1 * 33]); o.y = pk2(s[2 * 33], s[3 * 33]); o.z = pk2(s[4 * 33], s[5 * 33]); o.w = pk2(s[6 * 33], s[7 * 33]);
        *(u32x4*)(WT + (size_t)(drow0 + n) * K + k0 + 8 * c) = o; }
    LDS_FENCE();
}
__device__ __forceinline__ void tr_matrix(const float* W, int ldw, int K, int col_off, int ncols, bf16* WT, int row_off, LAS float* scr, int gw, int NGW, int lane, int& base) {
    const int nblk = ncols / 32, nitems = (K / 64) * nblk;
    int it = gw - (base % NGW); if (it < 0) it += NGW;
    base += nitems;
    f32x4 cur[8];
    if (it < nitems) { const int kb = it / nblk, nb = it - kb * nblk; tr_load(cur, W, ldw, col_off + 32 * nb, 64 * kb, lane); }
    while (it < nitems) {
        const int kb = it / nblk, nb = it - kb * nblk, nx = it + NGW;
        f32x4 nxt[8];
        if (nx < nitems) { const int kb2 = nx / nblk, nb2 = nx - kb2 * nblk; tr_load(nxt, W, ldw, col_off + 32 * nb2, 64 * kb2, lane); }
        tr_store(cur, K, WT, row_off + 32 * nb, 64 * kb, scr, lane);
#pragma unroll
        for (int i = 0; i < 8; ++i) cur[i] = nxt[i];
        it = nx;
    }
}
__device__ __forceinline__ void rms_row(const float* __restrict__ xrow, const float* __restrict__ gain, bf16* orow, float* of32, const LAS f32x4* wfl, float* fl, int lane) {
    const f32x4* xr = (const f32x4*)xrow + lane; const f32x4* gr = (const f32x4*)gain + lane;
    f32x4 v[8]; float s = 0.f;
#pragma unroll
    for (int j = 0; j < 8; ++j) { v[j] = xr[64 * j]; s += (v[j].x * v[j].x + v[j].y * v[j].y) + (v[j].z * v[j].z + v[j].w * v[j].w); }
    const float r = rsqrtf(wave_sum(s) * (1.f / DM) + EPS);
#pragma unroll
    for (int j = 0; j < 8; ++j) v[j] = v[j] * r * gr[64 * j];
    if (of32) {
#pragma unroll
        for (int j = 0; j < 8; ++j) ((f32x4*)of32 + lane)[64 * j] = v[j];
    } else {
        u32x2* o8 = (u32x2*)orow + lane;
#pragma unroll
        for (int j = 0; j < 8; ++j) { u32x2 w; w.x = pk2(v[j].x, v[j].y); w.y = pk2(v[j].z, v[j].w); o8[64 * j] = w; }
    }
    if (fl) {
        f32x4 p0 = (f32x4){0.f, 0.f, 0.f, 0.f}, p1 = (f32x4){0.f, 0.f, 0.f, 0.f};
#pragma unroll
        for (int j = 0; j < 8; ++j)
#pragma unroll
            for (int e = 0; e < 4; ++e) { const f32x4 w0 = wfl[((j * 4 + e) * 2 + 0) * 64 + lane], w1 = wfl[((j * 4 + e) * 2 + 1) * 64 + lane]; p0 += w0 * v[j][e]; p1 += w1 * v[j][e]; }
#pragma unroll
        for (int e = 0; e < 4; ++e) { p0[e] = wave_sum(p0[e]); p1[e] = wave_sum(p1[e]); }
        if (lane == 0) { *(f32x4*)fl = p0; *(f32x4*)(fl + 4) = p1; }
    }
}
__device__ __forceinline__ void rms_rows(const float* X, const float* gain, bf16* O, float* OF, int nrows, int gw, int NGW, int lane, const LAS f32x4* wfl = nullptr, float* FL = nullptr) {
    for (int m = gw; m < nrows; m += NGW) rms_row(X + (size_t)m * DM, gain, O ? O + (size_t)m * DM : nullptr, OF ? OF + (size_t)m * DM : nullptr, wfl, FL ? FL + (size_t)m * 8 : nullptr, lane);
}

__device__ __forceinline__ void tr_bf16_64x64(const bf16* __restrict__ src, size_t lds_, bf16* __restrict__ dst, size_t ldd, LAS unsigned char* scr, int lane) {
#pragma unroll
    for (int i = 0; i < 8; ++i) { const int id = i * 64 + lane, r = id >> 3, ch = id & 7;
        const u32x4 v = *(const u32x4*)(src + (size_t)r * lds_ + ch * 8);
#pragma unroll
        for (int e = 0; e < 4; ++e) { const unsigned w = v[e]; const int c = ch * 8 + 2 * e;
            *(LAS unsigned short*)(scr + c * 144 + r * 2) = (unsigned short)(w & 0xffffu); *(LAS unsigned short*)(scr + (c + 1) * 144 + r * 2) = (unsigned short)(w >> 16); } }
    LDS_FENCE();
#pragma unroll
    for (int i = 0; i < 8; ++i) { const int id = i * 64 + lane, c = id >> 3, ch = id & 7;
        const u32x4 v = *(const LAS u32x4*)(scr + c * 144 + ch * 16);
        *(u32x4*)(dst + (size_t)c * ldd + ch * 8) = v; }
    LDS_FENCE();
}
constexpr int AT_KP = 272, AT_VP = 144, AT_KB = 64 * AT_KP, AT_VB = 128 * AT_VP;
constexpr int AT_VOFF = 2 * AT_KB;
template <int MODE>
__device__ __forceinline__ void attn_unit(LAS unsigned char* lds, const bf16* __restrict__ Qp, int ldq, const bf16* __restrict__ Kp, int ldk, const bf16* __restrict__ VTp, int ldvt,
                                          bf16* __restrict__ Op, int ldo, int q0, int nkeys, const float* __restrict__ c2, float l2g, const bf16* __restrict__ gate) {
    int tid_ = threadIdx.x; asm volatile("" : "+v"(tid_));
    const int tid = tid_, w = __builtin_amdgcn_readfirstlane(tid >> 6), lane = tid & 63, g4 = lane >> 4, c16 = lane & 15;
    const int ntiles = (MODE == 2) ? (nkeys >> 6) : ((q0 + 256) >> 6);
    const int qw0 = q0 + w * 32;
    const int tmax = (MODE == 2) ? ntiles - 1 : ((qw0 + 31) >> 6);
    __syncthreads();
    bf16x8 qf[2][4];
#pragma unroll
    for (int qs = 0; qs < 2; ++qs)
#pragma unroll
        for (int dk = 0; dk < 4; ++dk) { const size_t qo = (size_t)(qw0 + qs * 16 + c16) * ldq + dk * 32 + g4 * 8;
            if (MODE == 2) { const u32x4 qa = *(const u32x4*)(Qp + qo), qb2 = *(const u32x4*)(gate + qo); u32x4 qsum;
#pragma unroll
                for (int e = 0; e < 4; ++e) qsum[e] = pk2(bflo(qa[e]) + bflo(qb2[e]), bfhi(qa[e]) + bfhi(qb2[e]));
                qf[qs][dk] = __builtin_bit_cast(bf16x8, qsum);
            } else qf[qs][dk] = *(const bf16x8*)(Qp + qo); }
    f32x4 dkf[4];
    if (MODE == 1) {
#pragma unroll
        for (int kb = 0; kb < 4; ++kb)
#pragma unroll
            for (int j = 0; j < 4; ++j) dkf[kb][j] = __builtin_amdgcn_exp2f(-l2g * (float)(kb * 16 + g4 * 4 + j));
    }
    const int kr0 = tid >> 4, kc = tid & 15;
    const int vr0 = tid >> 3, vc = tid & 7;
    u32x4 kreg[2], vreg[2];
#define AT_LOAD(t) do { \
        kreg[0] = *(const u32x4*)(Kp + (size_t)((t) * 64 + kr0) * ldk + kc * 8); kreg[1] = *(const u32x4*)(Kp + (size_t)((t) * 64 + kr0 + 32) * ldk + kc * 8); \
        vreg[0] = *(const u32x4*)(VTp + (size_t)vr0 * ldvt + (t) * 64 + vc * 8); vreg[1] = *(const u32x4*)(VTp + (size_t)(vr0 + 64) * ldvt + (t) * 64 + vc * 8); } while (0)
#define AT_STORE(b) do { \
        *(LAS u32x4*)(lds + (b) * AT_KB + kr0 * AT_KP + kc * 16) = kreg[0]; *(LAS u32x4*)(lds + (b) * AT_KB + (kr0 + 32) * AT_KP + kc * 16) = kreg[1]; \
        *(LAS u32x4*)(lds + AT_VOFF + (b) * AT_VB + vr0 * AT_VP + vc * 16) = vreg[0]; *(LAS u32x4*)(lds + AT_VOFF + (b) * AT_VB + (vr0 + 64) * AT_VP + vc * 16) = vreg[1]; } while (0)
    f32x4 O[8][2];
#pragma unroll
    for (int db = 0; db < 8; ++db) { O[db][0] = (f32x4){0.f, 0.f, 0.f, 0.f}; O[db][1] = (f32x4){0.f, 0.f, 0.f, 0.f}; }
    float mrun[2] = {-INFINITY, -INFINITY}, lsum[2] = {0.f, 0.f};
    AT_LOAD(0); AT_STORE(0);
    __syncthreads();
    for (int t = 0; t < ntiles; ++t) {
        const int cur = t & 1;
        if (t + 1 < ntiles) AT_LOAD(t + 1);
        if (t <= tmax) {
            const LAS unsigned char* Ks = lds + cur * AT_KB; const LAS unsigned char* Vs = lds + AT_VOFF + cur * AT_VB;
            f32x4 S[4][2];
#pragma unroll
            for (int kb = 0; kb < 4; ++kb) { S[kb][0] = (f32x4){0.f, 0.f, 0.f, 0.f}; S[kb][1] = (f32x4){0.f, 0.f, 0.f, 0.f};
#pragma unroll
                for (int dk = 0; dk < 4; ++dk) { const bf16x8 kf = *(const LAS bf16x8*)(Ks + (kb * 16 + c16) * AT_KP + dk * 64 + g4 * 16);
                    S[kb][0] = __builtin_amdgcn_mfma_f32_16x16x32_bf16(kf, qf[0][dk], S[kb][0], 0, 0, 0);
                    S[kb][1] = __builtin_amdgcn_mfma_f32_16x16x32_bf16(kf, qf[1][dk], S[kb][1], 0, 0, 0); } }
            const int kbase = t * 64 + g4 * 4;
            const bool diag = (MODE != 2) && (t * 64 + 63 > qw0);
            if (MODE == 1) {
#pragma unroll
                for (int qs = 0; qs < 2; ++qs) { const int qpos = qw0 + qs * 16 + c16;
                    const float dq = __builtin_amdgcn_exp2f(l2g * (float)(qpos - t * 64));
#pragma unroll
                    for (int kb = 0; kb < 4; ++kb)
#pragma unroll
                        for (int j = 0; j < 4; ++j) { float p = (S[kb][qs][j] * dq) * dkf[kb][j];
                            if (diag && (kbase + kb * 16 + j > qpos)) p = 0.f;
                            S[kb][qs][j] = p; } }
            } else {
                f32x4 ck[4];
                if (MODE == 0) {
#pragma unroll
                    for (int kb = 0; kb < 4; ++kb) ck[kb] = *(const f32x4*)(c2 + kbase + kb * 16);
                }
#pragma unroll
                for (int qs = 0; qs < 2; ++qs) { const int qpos = qw0 + qs * 16 + c16; float mx = -INFINITY;
#pragma unroll
                    for (int kb = 0; kb < 4; ++kb)
#pragma unroll
                        for (int j = 0; j < 4; ++j) { float s = S[kb][qs][j] * (QK_SCALE * LOG2E);
                            if (MODE == 0) { s -= ck[kb][j]; if (diag && (kbase + kb * 16 + j > qpos)) s = -INFINITY; }
                            S[kb][qs][j] = s; mx = fmaxf(mx, s); }
                    mx = fmaxf(mx, __shfl_xor(mx, 16)); mx = fmaxf(mx, __shfl_xor(mx, 32));
                    const float mnew = fmaxf(mrun[qs], mx);
                    const float alpha = __builtin_amdgcn_exp2f(mrun[qs] - mnew);
                    mrun[qs] = mnew; float ps = 0.f;
#pragma unroll
                    for (int kb = 0; kb < 4; ++kb)
#pragma unroll
                        for (int j = 0; j < 4; ++j) { const float p = __builtin_amdgcn_exp2f(S[kb][qs][j] - mnew); S[kb][qs][j] = p; ps += p; }
                    lsum[qs] = lsum[qs] * alpha + ps;
#pragma unroll
                    for (int db = 0; db < 8; ++db) O[db][qs] = O[db][qs] * alpha; }
            }
#pragma unroll
            for (int k2 = 0; k2 < 2; ++k2) {
                bf16x8 pb[2];
#pragma unroll
                for (int qs = 0; qs < 2; ++qs) { u32x4 pw; pw.x = pk2(S[2 * k2][qs][0], S[2 * k2][qs][1]); pw.y = pk2(S[2 * k2][qs][2], S[2 * k2][qs][3]);
                    pw.z = pk2(S[2 * k2 + 1][qs][0], S[2 * k2 + 1][qs][1]); pw.w = pk2(S[2 * k2 + 1][qs][2], S[2 * k2 + 1][qs][3]); pb[qs] = __builtin_bit_cast(bf16x8, pw); }
#pragma unroll
                for (int db = 0; db < 8; ++db) { const LAS unsigned char* vp = Vs + (db * 16 + c16) * AT_VP + k2 * 64 + g4 * 8;
                    const u32x2 v0 = *(const LAS u32x2*)vp, v1 = *(const LAS u32x2*)(vp + 32);
                    u32x4 vw; vw.x = v0.x; vw.y = v0.y; vw.z = v1.x; vw.w = v1.y; const bf16x8 vf = __builtin_bit_cast(bf16x8, vw);
                    O[db][0] = __builtin_amdgcn_mfma_f32_16x16x32_bf16(vf, pb[0], O[db][0], 0, 0, 0);
                    O[db][1] = __builtin_amdgcn_mfma_f32_16x16x32_bf16(vf, pb[1], O[db][1], 0, 0, 0); }
            }
        }
        if (t + 1 < ntiles) AT_STORE(cur ^ 1);
        __syncthreads();
    }
#undef AT_LOAD
#undef AT_STORE
#pragma unroll
    for (int qs = 0; qs < 2; ++qs) {
        if (MODE == 1) {
            float s = 0.f;
#pragma unroll
            for (int db = 0; db < 8; ++db) s += (O[db][qs][0] + O[db][qs][1]) + (O[db][qs][2] + O[db][qs][3]);
            s += __shfl_xor(s, 16); s += __shfl_xor(s, 32);
            const float mu = s * (1.f / 128.f); float q = 0.f;
#pragma unroll
            for (int db = 0; db < 8; ++db) { O[db][qs] = O[db][qs] - mu; q += (O[db][qs][0] * O[db][qs][0] + O[db][qs][1] * O[db][qs][1]) + (O[db][qs][2] * O[db][qs][2] + O[db][qs][3] * O[db][qs][3]); }
            q += __shfl_xor(q, 16); q += __shfl_xor(q, 32);
            const float rs = rsqrtf(q * (1.f / 128.f) + EPS);
#pragma unroll
            for (int db = 0; db < 8; ++db) O[db][qs] = O[db][qs] * rs;
        } else {
            float l = lsum[qs]; l += __shfl_xor(l, 16); l += __shfl_xor(l, 32);
            const float inv = 1.f / l;
#pragma unroll
            for (int db = 0; db < 8; ++db) O[db][qs] = O[db][qs] * inv;
        }
    }
    LAS unsigned char* Os = lds + w * (32 * AT_KP);
#pragma unroll
    for (int qs = 0; qs < 2; ++qs)
#pragma unroll
        for (int db = 0; db < 8; ++db) { u32x2 wv; wv.x = pk2(O[db][qs][0], O[db][qs][1]); wv.y = pk2(O[db][qs][2], O[db][qs][3]);
            *(LAS u32x2*)(Os + (qs * 16 + c16) * AT_KP + (db * 16 + g4 * 4) * 2) = wv; }
    LDS_FENCE();
#pragma unroll
    for (int i = 0; i < 8; ++i) { const int id = i * 64 + lane, r = id >> 4, ch = id & 15;
        u32x4 v = *(const LAS u32x4*)(Os + r * AT_KP + ch * 16);
        if (MODE == 1) { const u32x4 gv = *(const u32x4*)(gate + (size_t)(qw0 + r) * ldq + ch * 8);
#pragma unroll
            for (int e = 0; e < 4; ++e) { const float g0 = bflo(gv[e]), g1 = bfhi(gv[e]);
                const float o0 = bflo(v[e]) * (g0 / (1.f + __expf(-g0))), o1 = bfhi(v[e]) * (g1 / (1.f + __expf(-g1))); v[e] = pk2(o0, o1); } }
        *(u32x4*)(Op + (size_t)(qw0 + r) * ldo + ch * 8) = v; }
}
constexpr int S5_BUP = 80;
constexpr int S5_WAVE = 128 * S5_BUP + 16 * 272;
constexpr int S5_XCH = 8 * S5_WAVE;
struct S5P { const float *a_re, *a_im, *b_re, *b_im, *c_re, *c_im, *dsk, *lstep; };
__device__ __forceinline__ void s5_abar(const S5P& P, int g, int p, float& ar, float& ai, float& cr, float& ci) {
    const float lr = fminf(P.a_re[g * 64 + p], -1e-4f), li = P.a_im[g * 64 + p], st = __expf(P.lstep[g * 64 + p]);
    const float zr = lr * st, zi = li * st, mag = __expf(zr);
    const float rev = zi * 0.15915494309189535f; const float fr = rev - floorf(rev);
    ar = mag * __builtin_amdgcn_cosf(fr); ai = mag * __builtin_amdgcn_sinf(fr);
    const float nr = ar - 1.f, ni = ai, den = 1.f / (lr * lr + li * li);
    cr = (nr * lr + ni * li) * den; ci = (ni * lr - nr * li) * den;
}
__device__ __forceinline__ float gelu_tanh(float y) {
    const float u = 0.7978845608028654f * (y + 0.044715f * y * y * y);
    const float t = __builtin_amdgcn_exp2f(u * (2.f * LOG2E));
    const float th = 1.f - 2.f / (t + 1.f);
    return 0.5f * y * (1.f + th);
}
__device__ __forceinline__ void s5_unit(LAS unsigned char* lds, int b, int g, const bf16* __restrict__ PROJ, bf16* __restrict__ GB, const S5P& P) {
    int tid_ = threadIdx.x; asm volatile("" : "+v"(tid_));
    const int tid = tid_, w = __builtin_amdgcn_readfirstlane(tid >> 6), lane = tid & 63, g4 = lane >> 4, c16 = lane & 15;
    LAS unsigned char* Bs = lds + w * S5_WAVE; LAS unsigned char* Xs = Bs + 128 * S5_BUP; LAS float* xch = (LAS float*)(lds + S5_XCH);
    __syncthreads();
    float ar, ai, tcr, tci; s5_abar(P, g, lane, ar, ai, tcr, tci);
    bf16x8 Bb[8];
#pragma unroll
    for (int q = 0; q < 4; ++q) { const int pp = q * 16 + c16; float a0, a1, cr, ci; s5_abar(P, g, pp, a0, a1, cr, ci);
        unsigned wr_[4], wi_[4];
#pragma unroll
        for (int e = 0; e < 4; ++e) { float re[2], im[2];
#pragma unroll
            for (int h = 0; h < 2; ++h) { const int c = (g4 & 1) * 8 + 2 * e + h; const float br = P.b_re[((size_t)g * 64 + pp) * 16 + c], bi = P.b_im[((size_t)g * 64 + pp) * 16 + c];
                re[h] = cr * br - ci * bi; im[h] = cr * bi + ci * br; }
            wr_[e] = (g4 < 2) ? pk2(re[0], re[1]) : 0u; wi_[e] = (g4 < 2) ? pk2(im[0], im[1]) : 0u; }
        u32x4 a; a.x = wr_[0]; a.y = wr_[1]; a.z = wr_[2]; a.w = wr_[3]; Bb[q] = __builtin_bit_cast(bf16x8, a);
        u32x4 c; c.x = wi_[0]; c.y = wi_[1]; c.z = wi_[2]; c.w = wi_[3]; Bb[4 + q] = __builtin_bit_cast(bf16x8, c); }
    bf16x8 Cb[4];
#pragma unroll
    for (int kb = 0; kb < 4; ++kb) { unsigned wv[4];
#pragma unroll
        for (int e = 0; e < 4; ++e) { const int pidx = kb * 16 + g4 * 4 + e; const size_t ix = ((size_t)g * 16 + c16) * 64 + pidx; wv[e] = pk2(P.c_re[ix], -P.c_im[ix]); }
        u32x4 a; a.x = wv[0]; a.y = wv[1]; a.z = wv[2]; a.w = wv[3]; Cb[kb] = __builtin_bit_cast(bf16x8, a); }
    const float dsk = P.dsk[g * 16 + c16];
    const bf16* urow = PROJ + (size_t)(b * SEQ) * ODD_IN + g * 16;
    float xr = 0.f, xi = 0.f;
    for (int pass = 0; pass < 2; ++pass) {
        u32x4 uw = (u32x4){0u, 0u, 0u, 0u}; unsigned short us[4] = {0, 0, 0, 0};
        { const int tok0 = w * 512;
          if (g4 < 2) uw = *(const u32x4*)(urow + (size_t)(tok0 + c16) * ODD_IN + g4 * 8);
          if (pass == 1) {
#pragma unroll
              for (int j = 0; j < 4; ++j) us[j] = urow[(size_t)(tok0 + g4 * 4 + j) * ODD_IN + c16]; } }
        for (int blk = 0; blk < 32; ++blk) {
            const int tok0 = w * 512 + blk * 16;
            u32x4 uwn = (u32x4){0u, 0u, 0u, 0u}; unsigned short usn[4] = {0, 0, 0, 0};
            if (blk + 1 < 32) { const int tok1 = tok0 + 16;
                if (g4 < 2) uwn = *(const u32x4*)(urow + (size_t)(tok1 + c16) * ODD_IN + g4 * 8);
                if (pass == 1) {
#pragma unroll
                    for (int j = 0; j < 4; ++j) usn[j] = urow[(size_t)(tok1 + g4 * 4 + j) * ODD_IN + c16]; } }
            const bf16x8 ua = __builtin_bit_cast(bf16x8, uw);
#pragma unroll
            for (int nb = 0; nb < 8; ++nb) { f32x4 acc = (f32x4){0.f, 0.f, 0.f, 0.f};
                acc = __builtin_amdgcn_mfma_f32_16x16x32_bf16(ua, Bb[nb], acc, 0, 0, 0);
                *(LAS f32x4*)(Bs + (nb * 16 + c16) * S5_BUP + g4 * 16) = acc; }
            __syncthreads();
#pragma unroll
            for (int k = 0; k < 4; ++k) { const f32x4 br = *(const LAS f32x4*)(Bs + lane * S5_BUP + k * 16), bi = *(const LAS f32x4*)(Bs + (64 + lane) * S5_BUP + k * 16);
#pragma unroll
                for (int j = 0; j < 4; ++j) { const float nr = ar * xr - ai * xi + br[j], ni = ar * xi + ai * xr + bi[j]; xr = nr; xi = ni;
                    if (pass == 1) *(LAS unsigned*)(Xs + (k * 4 + j) * 272 + lane * 4) = pk2(xr, xi); } }
            if (pass == 1) {
                __syncthreads();
                f32x4 y = (f32x4){0.f, 0.f, 0.f, 0.f};
#pragma unroll
                for (int kb = 0; kb < 4; ++kb) { const bf16x8 xa = *(const LAS bf16x8*)(Xs + c16 * 272 + kb * 64 + g4 * 16); y = __builtin_amdgcn_mfma_f32_16x16x32_bf16(xa, Cb[kb], y, 0, 0, 0); }
#pragma unroll
                for (int j = 0; j < 4; ++j) { const int tok = tok0 + g4 * 4 + j; const float u = __uint_as_float((unsigned)us[j] << 16);
                    const float v = gelu_tanh(y[j] + dsk * u);
                    GB[(size_t)(b * SEQ + tok) * 1024 + g * 16 + c16] = (bf16)f2bf(v); }
            }
            __syncthreads();
            uw = uwn;
#pragma unroll
            for (int j = 0; j < 4; ++j) us[j] = usn[j];
        }
        if (pass == 0) {
            xch[(w * 64 + lane) * 2] = xr; xch[(w * 64 + lane) * 2 + 1] = xi;
            __syncthreads();
            float pr = ar, pi = ai;
#pragma unroll
            for (int s = 0; s < 9; ++s) { const float nr = pr * pr - pi * pi, ni = 2.f * pr * pi; pr = nr; pi = ni; }
            xr = 0.f; xi = 0.f;
            for (int j = 0; j < w; ++j) { const float er = xch[(j * 64 + lane) * 2], ei = xch[(j * 64 + lane) * 2 + 1];
                const float nr = pr * xr - pi * xi + er, ni = pr * xi + pi * xr + ei; xr = nr; xi = ni; }
        }
    }
}
#define x_in IN(0)
#define H ((float*)(ws + WS_H))
#define XN ((bf16*)(ws + WS_XN))
#define PROJ ((bf16*)(ws + WS_PROJ))
#define MIX ((bf16*)(ws + WS_MIX))
#define VT ((bf16*)(ws + WS_VT))
#define GB ((bf16*)(ws + WS_VT))
#define QX ((bf16*)(ws + WS_QX))
#define XO ((bf16*)(ws + WS_XO))
#define FLOG ((float*)(ws + WS_FLOG))
#define C2 ((float*)(ws + WS_C2))
#define MEMN ((bf16*)(ws + WS_MEMN))
#define KVX ((bf16*)(ws + WS_KVX))
#define VTX ((bf16*)(ws + WS_VTX))
#define ROPE ((float*)(ws + WS_ROPE))
#define WKVT ((bf16*)(ws + WS_WKVT))
#define WINT ((bf16*)(ws + WS_WINT))
#define WOUTT ((bf16*)(ws + WS_WOUTT))
#define WQT ((bf16*)(ws + WS_WQT))
#define WOT ((bf16*)(ws + WS_WOT))
#define W1T ((bf16*)(ws + WS_W1T))
#define W2T ((bf16*)(ws + WS_W2T))
#define WGLUT ((bf16*)(ws + WS_WGLUT))
#define IN(i) ((const float*)(const __attribute__((address_space(1))) float*)(unsigned long long)(args.in[(i) + zz]))
#define run_gemm(lds, ...) run_gemm_(lds, G, bid, __VA_ARGS__)
constexpr int PH_PER_LAYER = 12, N_PHASES = DEPTH * PH_PER_LAYER + 1;
using GOrder = pg8::StaticOrder;
template <class Epi> __device__ __forceinline__ void run_gemm_(LAS unsigned char* lds, int G, int bid, const bf16* A, const bf16* Bt, int M, int N, int K, const Epi& E, int ld = 0, int rot = 0) {
    pg8::Gemm g{A, Bt, M, N, K, ld ? ld : K}; GOrder S; int c = bid + rot; if (c >= G) c -= G; S.init(M, N, G, c);
#ifndef NO_GEMM
    pg8::gemm_phase<Epi, GOrder, true, true>(lds, g, S, E);
#endif
}

#define RLX_AGENT __ATOMIC_RELAXED, __HIP_MEMORY_SCOPE_AGENT
#define XB_TMO      128
#define XB_XCNT(j)  (256  + 64 * (j))
#define XB_XSUB(j)  (1280 + 64 * (j))
#define XB_XGEN(j)  (2304 + 64 * (j))
#define XB_TOP      3328
#define XB_TOPGEN   3392
#define XCD_BAR_WORDS 3456
#define XB_SPIN_CAP (1u << 23)

__device__ __forceinline__ unsigned xb_ld(unsigned* p)              { return __hip_atomic_load(p, __ATOMIC_RELAXED, __HIP_MEMORY_SCOPE_AGENT); }
__device__ __forceinline__ unsigned xb_add(unsigned* p, unsigned v) { return __hip_atomic_fetch_add(p, v, __ATOMIC_RELAXED, __HIP_MEMORY_SCOPE_AGENT); }
__device__ __forceinline__ unsigned xb_xcc_id() { return (unsigned)__builtin_amdgcn_s_getreg((3 << 11) | 20) & 0xFu; }
#define XB_SPIN(cond, bar) do { unsigned _sp = 0; while (cond) { __builtin_amdgcn_s_sleep(1); \
    if ((++_sp & 255u) == 0u) { if (xb_ld(&(bar)[XB_TMO])) break; if (_sp > XB_SPIN_CAP) { atomicAdd(&(bar)[XB_TMO], 1u); break; } } } } while (0)

struct XcdBarrier {
    unsigned* bar; unsigned x;
    volatile LAS unsigned* st;
};

__device__ __forceinline__ XcdBarrier xcd_barrier_post(unsigned* bar, volatile LAS unsigned* st) {
    XcdBarrier b; b.bar = bar; b.x = xb_xcc_id(); b.st = st;
    if (threadIdx.x == 0) (void)xb_add(&bar[XB_XCNT(b.x)], 1u);
    return b;
}
__device__ __forceinline__ void xcd_barrier_complete(unsigned* bar, unsigned x, unsigned& nloc, unsigned& nx) {
    const unsigned G = gridDim.x * gridDim.y * gridDim.z;
    unsigned sum, cnt, mine, sp = 0u;
    for (;;) {
        sum = 0u; cnt = 0u; mine = 0u;
#pragma unroll
        for (unsigned j = 0; j < 16; ++j) { const unsigned c = xb_ld(&bar[XB_XCNT(j)]); sum += c; cnt += (c > 0u) ? 1u : 0u; mine = (j == x) ? c : mine; }
        if (sum == G) break;
        __builtin_amdgcn_s_sleep(1);
        if ((++sp & 255u) == 0u) { if (xb_ld(&bar[XB_TMO])) break; if (sp > XB_SPIN_CAP) { atomicAdd(&bar[XB_TMO], 1u); break; } }
    }
    nloc = mine > 0u ? mine : 1u; nx = cnt > 0u ? cnt : 1u;
}

__device__ __forceinline__ void xcd_barrier(const XcdBarrier& b) {
    asm volatile("s_waitcnt vmcnt(0)" ::: "memory");
    __syncthreads();
    if (threadIdx.x == 0) {
        unsigned* bar = b.bar;
        __builtin_amdgcn_s_waitcnt(0);
        unsigned nloc = b.st[0], nx = b.st[1];
        if (nloc == 0u) { xcd_barrier_complete(bar, b.x, nloc, nx); b.st[0] = nloc; b.st[1] = nx; }
        const unsigned old = xb_add(&bar[XB_XSUB(b.x)], 1u);
        const unsigned gen = old / nloc;
        if (old + 1u == (gen + 1u) * nloc) {
            __builtin_amdgcn_fence(__ATOMIC_RELEASE, "agent");
            asm volatile("s_waitcnt vmcnt(0)" ::: "memory");
            const unsigned og = xb_add(&bar[XB_TOP], 1u);
            const unsigned tg = og / nx;
            if (og + 1u == (tg + 1u) * nx) xb_add(&bar[XB_TOPGEN], 1u);
            else XB_SPIN(xb_ld(&bar[XB_TOPGEN]) == tg, bar);
            __builtin_amdgcn_fence(__ATOMIC_ACQUIRE, "agent");
            xb_add(&bar[XB_XGEN(b.x)], 1u);
            asm volatile("s_waitcnt vmcnt(0)" ::: "memory");
        } else {
            XB_SPIN(xb_ld(&bar[XB_XGEN(b.x)]) == gen, bar);
            __builtin_amdgcn_fence(__ATOMIC_ACQUIRE, "agent");
            asm volatile("s_waitcnt vmcnt(0)" ::: "memory");
        }
    }
    __syncthreads();
}

__device__ __forceinline__ void grid_bar(unsigned* cnt, unsigned target) {
#ifdef DBG_DELAY
    { const unsigned long long t0 = __builtin_amdgcn_s_memrealtime(); while (__builtin_amdgcn_s_memrealtime() - t0 < (unsigned long long)DBG_DELAY) __builtin_amdgcn_s_sleep(8); }
#endif
    asm volatile("s_waitcnt vmcnt(0) lgkmcnt(0)" ::: "memory");
    __syncthreads();
    if (threadIdx.x == 0) {
        __builtin_amdgcn_fence(__ATOMIC_RELEASE, "");
        asm volatile("s_waitcnt vmcnt(0)" ::: "memory");
        __hip_atomic_fetch_add(cnt, 1u, __ATOMIC_RELAXED, __HIP_MEMORY_SCOPE_AGENT);
        while (__hip_atomic_load(cnt, __ATOMIC_RELAXED, __HIP_MEMORY_SCOPE_AGENT) < target) __builtin_amdgcn_s_sleep(1);
        __builtin_amdgcn_fence(__ATOMIC_ACQUIRE, "");
        asm volatile("s_waitcnt vmcnt(0)" ::: "memory");
    }
    __syncthreads();
}
__global__ void __launch_bounds__(512, 2) trunk_fwd(Args args) {
    extern __shared__ __attribute__((aligned(16))) unsigned char lds_raw[];
    LAS unsigned char* lds = (LAS unsigned char*)lds_raw;
    cg::grid_group grid = cg::this_grid();
    const int lo = args.ph_lo, hi = args.ph_hi;
    int ph = 0; unsigned nbar = 0; (void)nbar;
    if (threadIdx.x < 2) ((volatile LAS unsigned*)(lds + LDS_BYTES - 64))[threadIdx.x] = 0u;
    __syncthreads();
    XcdBarrier xbar = xcd_barrier_post((unsigned*)args.ws, (volatile LAS unsigned*)(lds + LDS_BYTES - 64));
#ifdef DBG_LDSFILL
    for (int i = threadIdx.x; i < LDS_BYTES / 16; i += 512) ((LAS u32x4*)lds)[i] = (u32x4){0u, 0u, 0u, 0u};
    __syncthreads();
#endif
#ifdef DBG_FILL
    { u32x4* p = (u32x4*)(args.ws + MiB); const size_t n = (WS_END - MiB) / 16; for (size_t i = (size_t)blockIdx.x * 512 + threadIdx.x; i < n; i += (size_t)gridDim.x * 512) p[i] = (u32x4){0u, 0u, 0u, 0u}; }
#endif
    if (hi - lo > 1) grid.sync();
#ifndef DBG_NPH
#define DBG_NPH 1000
#endif
#define PH_BEGIN if (ph >= lo && ph < hi && (ph < DBG_NPH || ph == N_PHASES - 1)) { __attribute__((address_space(1))) unsigned char* ws = (__attribute__((address_space(1))) unsigned char*)(unsigned long long)args.ws; int zz = 0; int tid = threadIdx.x; int G = gridDim.x; int bid = blockIdx.x; asm volatile("" : "+s"(ws), "+s"(zz), "+v"(tid), "+s"(G), "+s"(bid)); const int lane = tid & 63, wave = __builtin_amdgcn_readfirstlane(tid >> 6), gw = bid * 8 + wave, NGW = G * 8; (void)lane; (void)gw; (void)NGW;
#ifdef DBG_DUP_BAR
#define PH_END } if (ph >= lo && ph + 1 < hi) { ++nbar; grid_bar((unsigned*)args.ws, nbar * gridDim.x); ++nbar; grid_bar((unsigned*)args.ws, nbar * gridDim.x); } ++ph;
#else
#define PH_END } if (ph >= lo && ph + 1 < hi) { xcd_barrier(xbar); } ++ph;
#endif

#ifdef DBG_COPYX
    { const float* xs = args.in[0]; for (size_t i = (size_t)blockIdx.x * 512 + threadIdx.x; i < (size_t)NT * DM; i += (size_t)gridDim.x * 512) args.out[i] = xs[i]; return; }
#endif
#ifdef DBG_BARTEST
    { float* flag = (float*)(args.ws + 512 * 1024);
      if (blockIdx.x == 5) { const unsigned long long t0 = __builtin_amdgcn_s_memrealtime(); while (__builtin_amdgcn_s_memrealtime() - t0 < 300000ull) __builtin_amdgcn_s_sleep(8);
          if (threadIdx.x == 0) flag[0] = 1234.5f; }
#if DBG_BARTEST == 1
      ++nbar; grid_bar((unsigned*)args.ws, nbar * gridDim.x);
#else
      grid.sync();
#endif
      const float f = __hip_atomic_load(flag, __ATOMIC_RELAXED, __HIP_MEMORY_SCOPE_AGENT);
      for (size_t i = (size_t)blockIdx.x * 512 + threadIdx.x; i < (size_t)NT * DM; i += (size_t)gridDim.x * 512) args.out[i] = f;
      return; }
#endif
#pragma unroll 1
    for (int layer = 0; layer < DEPTH; ++layer) {
        const bool even = (layer & 1) == 0;
#ifdef DBG_SUB0
        const int sub = 0;
#else
        const int sub = layer >> 1;
#endif
        PH_BEGIN
            LAS float* scr = (LAS float*)(lds + wave * 16384); int tbase = 0;
#ifdef DBG_DUP_A
            for (int rep = 0; rep < 2; ++rep) {
#endif
            if (layer == 0) {
                rms_rows(IN(1), IN(5), MEMN, nullptr, NB * MEML, gw, NGW, lane);
                for (int l = 0; l < DEPTH; ++l) tr_matrix(IN(23) + (size_t)l * DM * 1024, 1024, DM, 0, 1024, WKVT, l * 1024, scr, gw, NGW, lane, tbase);
                for (int idx = bid * 512 + tid; idx < SEQ * 64; idx += G * 512) { const int pos = idx >> 6, i = idx & 63;
                    const float inv = powf(10000.f, -(float)i * (1.f / 64.f)); const float ang = (float)pos * inv;
                    const double rev = (double)ang * 0.15915494309189535; const float fr = (float)(rev - floor(rev));
                    ROPE[idx] = __builtin_amdgcn_cosf(fr); ROPE[SEQ * 64 + idx] = __builtin_amdgcn_sinf(fr); }
            }
            if (even) {
                const float* Win = IN(7) + (size_t)sub * DM * EVEN_IN;
                tr_matrix(Win, EVEN_IN, DM, 0, 3072, WINT, 0, scr, gw, NGW, lane, tbase);
                tr_matrix(Win, EVEN_IN, DM, 3080, 4096, WINT, 3072, scr, gw, NGW, lane, tbase);
                tr_matrix(IN(9) + (size_t)sub * DM * DM, DM, DM, 0, DM, WOUTT, 0, scr, gw, NGW, lane, tbase);
            } else {
                tr_matrix(IN(10) + (size_t)sub * DM * ODD_IN, ODD_IN, DM, 0, ODD_IN, WINT, 0, scr, gw, NGW, lane, tbase);
                tr_matrix(IN(19) + (size_t)sub * 1024 * 1024, 1024, 1024, 0, 1024, WGLUT, 0, scr, gw, NGW, lane, tbase);
                tr_matrix(IN(21) + (size_t)sub * DM * DM, DM, DM, 0, DM, WOUTT, 0, scr, gw, NGW, lane, tbase);
            }
            tr_matrix(IN(22) + (size_t)layer * DM * XAW, XAW, DM, 0, XAW, WQT, 0, scr, gw, NGW, lane, tbase);
            tr_matrix(IN(24) + (size_t)layer * XAW * DM, DM, XAW, 0, DM, WOT, 0, scr, gw, NGW, lane, tbase);
            tr_matrix(IN(25) + (size_t)layer * DM * DFF, DFF, DM, 0, DFF, W1T, 0, scr, gw, NGW, lane, tbase);
            tr_matrix(IN(26) + (size_t)layer * DFF * DM, DM, DFF, 0, DM, W2T, 0, scr, gw, NGW, lane, tbase);
            if (even) {
                __syncthreads();
                const float* wf = IN(7) + (size_t)sub * DM * EVEN_IN + 3072; LAS f32x4* wfl = (LAS f32x4*)lds;
                for (int i = tid; i < 4096; i += 512) { const int k = i >> 1, half = i & 1; wfl[((((k >> 8) * 4 + (k & 3)) * 2 + half) * 64) + ((k >> 2) & 63)] = *(const f32x4*)(wf + (size_t)k * EVEN_IN + half * 4); }
                __syncthreads();
                rms_rows((layer == 0) ? x_in : H, IN(2) + layer * DM, XN, nullptr, NT, gw, NGW, lane, wfl, FLOG);
            }
            else rms_rows((layer == 0) ? x_in : H, IN(2) + layer * DM, XN, nullptr, NT, gw, NGW, lane);
#ifdef DBG_DUP_A
            }
#endif
        PH_END
        PH_BEGIN
            if (even) { pg8::EpiBf E{PROJ, EVEN_LD, 0, nullptr, -1}; run_gemm(lds, XN, WINT, NT, EVEN_N, DM, E); }
#ifdef DBG_TWICE
            if (layer == 2) { pg8::EpiBf E2{MIX, DM, 0, nullptr, -1}; run_gemm(lds, XN, WINT, NT, DM, DM, E2); }
#endif
            else { pg8::EpiBf E{PROJ, ODD_IN, 0, nullptr, -1}; run_gemm(lds, XN, WINT, NT, ODD_IN, DM, E); }
            if (layer == 0) { pg8::EpiBf E{KVX, 4096, 0, nullptr, -1}; run_gemm(lds, MEMN, WKVT, NB * MEML, 4096, DM, E); }
        PH_END
        if (even) {
            PH_BEGIN
                if (bid < 32) {
                    const int b = bid >> 3, h = bid & 7; const float bias = IN(8)[sub * 8 + h];
                    float v[8]; float run = 0.f;
#pragma unroll
                    for (int e = 0; e < 8; ++e) { const float xx = FLOG[(size_t)(b * SEQ + tid * 8 + e) * 8 + h] + bias;
                        const float ls = fminf(xx, 0.f) - log1pf(__expf(-fabsf(xx))); run += ls; v[e] = run; }
                    float inc = run;
#pragma unroll
                    for (int o = 1; o < 64; o <<= 1) { const float t = __shfl_up(inc, o); if (lane >= o) inc += t; }
                    LAS float* wsum = (LAS float*)(lds + 131072);
                    __syncthreads();
                    if (lane == 63) wsum[wave] = inc;
                    __syncthreads();
                    float off = inc - run;
                    for (int j = 0; j < wave; ++j) off += wsum[j];
#pragma unroll
                    for (int e = 0; e < 8; ++e) C2[(size_t)(b * 8 + h) * SEQ + tid * 8 + e] = (v[e] + off) * LOG2E;
                }
                for (int t = gw; t < NT; t += NGW) { const int pos = t & (SEQ - 1), slot = lane >> 2, i0 = (lane & 3) * 16;
                    bf16* p1 = PROJ + (size_t)t * EVEN_LD + 3072 + slot * 128 + i0; bf16* p2 = p1 + 64;
                    const float sc = (slot >= 8) ? QK_SCALE : 1.f;
#pragma unroll
                    for (int hlf = 0; hlf < 2; ++hlf) { const u32x4 a = *(const u32x4*)(p1 + hlf * 8), c = *(const u32x4*)(p2 + hlf * 8); u32x4 o1, o2;
#pragma unroll
                        for (int e = 0; e < 4; ++e) { const int ii = i0 + hlf * 8 + 2 * e;
                            const float c0 = ROPE[pos * 64 + ii], c1 = ROPE[pos * 64 + ii + 1], s0 = ROPE[SEQ * 64 + pos * 64 + ii], s1 = ROPE[SEQ * 64 + pos * 64 + ii + 1];
                            const float a0 = bflo(a[e]), a1 = bfhi(a[e]), b0 = bflo(c[e]), b1 = bfhi(c[e]);
                            o1[e] = pk2((a0 * c0 - b0 * s0) * sc, (a1 * c1 - b1 * s1) * sc); o2[e] = pk2((a0 * s0 + b0 * c0) * sc, (a1 * s1 + b1 * c1) * sc); }
                        *(u32x4*)(p1 + hlf * 8) = o1; *(u32x4*)(p2 + hlf * 8) = o2; } }
                { LAS unsigned char* scr = lds + wave * 9216;
                  for (int it = gw; it < NB * 16 * 64 * 2; it += NGW) { const int dh = it & 1, tb = (it >> 1) & 63, h16 = (it >> 7) & 15, b = it >> 11;
                      const bf16* src = PROJ + (size_t)(b * SEQ + tb * 64) * EVEN_LD + (h16 < 8 ? 2048 + h16 * 128 : 5120 + (h16 - 8) * 128) + dh * 64;
                      bf16* dst = VT + ((size_t)(b * 16 + h16) * 128 + dh * 64) * SEQ + tb * 64;
                      tr_bf16_64x64(src, EVEN_LD, dst, SEQ, scr, lane); }
                  if (layer == 0) for (int it = gw; it < DEPTH * NB * 4 * 4 * 2; it += NGW) { const int dh = it & 1, kb = (it >> 1) & 3, h = (it >> 3) & 3, b = (it >> 5) & 3, l = it >> 7;
                      const bf16* src = KVX + (size_t)(b * MEML + kb * 64) * 4096 + l * 1024 + 512 + h * 128 + dh * 64;
                      bf16* dst = VTX + ((size_t)((l * NB + b) * 4 + h) * 128 + dh * 64) * MEML + kb * 64;
                      tr_bf16_64x64(src, 4096, dst, MEML, scr, lane); } }
            PH_END
            PH_BEGIN
                const int NU = NB * 16 * 16;
#ifdef DBG_DUP_ATTN
                for (int rep = 0; rep < 2; ++rep)
#endif
                for (int r = 0; r * G < NU; ++r) { const int sidx = r * G + ((r & 1) ? (G - 1 - bid) : bid); if (sidx >= NU) continue;
                    const int qb = 15 - (sidx >> 6), bh = sidx & 63, b = bh >> 4, h16 = bh & 15, h = h16 & 7;
                    const bf16* rowb = PROJ + (size_t)(b * SEQ) * EVEN_LD; const bf16* vt = VT + (size_t)(b * 16 + h16) * 128 * SEQ; bf16* ob = MIX + (size_t)(b * SEQ) * DM;
#ifndef NO_ATTN
                    if (h16 < 8) attn_unit<0>(lds, rowb + h * 128, EVEN_LD, rowb + 1024 + h * 128, EVEN_LD, vt, SEQ, ob + h * 128, DM, qb * 256, 0, C2 + (size_t)(b * 8 + h) * SEQ, 0.f, nullptr);
                    else { const float l2g = log2f(1.f - exp2f(-5.f - (float)h));
                        attn_unit<1>(lds, rowb + 3072 + h * 128, EVEN_LD, rowb + 4096 + h * 128, EVEN_LD, vt, SEQ, ob + 1024 + h * 128, DM, qb * 256, 0, nullptr, l2g, rowb + 6144 + h * 128); }
#endif
                }
            PH_END
        } else {
            PH_BEGIN
#ifdef DBG_DUP_S5
                for (int rep = 0; rep < 2; ++rep) {
#endif
                S5P P{IN(11) + sub * 4096, IN(12) + sub * 4096, IN(13) + (size_t)sub * 65536, IN(14) + (size_t)sub * 65536,
                      IN(15) + (size_t)sub * 65536, IN(16) + (size_t)sub * 65536, IN(17) + sub * 1024, IN(18) + sub * 4096};
#ifndef NO_S5
                for (int u = bid; u < NB * 64; u += G) s5_unit(lds, u >> 6, u & 63, PROJ, GB, P);
#endif
                const float* cw = IN(20) + sub * 3 * 1024;
                for (int idx = bid * 512 + tid; idx < NT * 128; idx += G * 512) { const int tok = idx >> 7, ch = (idx & 127) * 8, l = tok & (SEQ - 1);
                    const bf16* row = PROJ + (size_t)tok * ODD_IN;
                    float acc[8];
#pragma unroll
                    for (int e = 0; e < 8; ++e) acc[e] = 0.f;
#pragma unroll
                    for (int k = 0; k < 3; ++k) { const int back = 2 - k; if (l - back < 0) continue;
                        const u32x4 hv = *(const u32x4*)(row - (size_t)back * ODD_IN + 1024 + ch), gc = *(const u32x4*)(row - (size_t)back * ODD_IN + 3072 + ch);
                        const f32x4 w0 = *(const f32x4*)(cw + k * 1024 + ch), w1 = *(const f32x4*)(cw + k * 1024 + ch + 4);
#pragma unroll
                        for (int e = 0; e < 4; ++e) { const float wa = (e < 2) ? w0[2 * e] : w1[2 * e - 4], wb = (e < 2) ? w0[2 * e + 1] : w1[2 * e - 3];
                            acc[2 * e] += wa * (bflo(hv[e]) * bflo(gc[e])); acc[2 * e + 1] += wb * (bfhi(hv[e]) * bfhi(gc[e])); } }
                    const u32x4 gb = *(const u32x4*)(row + 2048 + ch); u32x4 o;
#pragma unroll
                    for (int e = 0; e < 4; ++e) o[e] = pk2(bflo(gb[e]) * acc[2 * e], bfhi(gb[e]) * acc[2 * e + 1]);
                    *(u32x4*)(MIX + (size_t)tok * DM + 1024 + ch) = o; }
#ifdef DBG_DUP_S5
                }
#endif
            PH_END
            PH_BEGIN
                pg8::EpiGlu E{GB, 1024, MIX, DM}; run_gemm(lds, GB, WGLUT, NT, 1024, 1024, E);
            PH_END
        }
        PH_BEGIN
            pg8::EpiResid E{(layer == 0) ? x_in : H, H, DM}; run_gemm(lds, MIX, WOUTT, NT, DM, DM, E);
        PH_END
        PH_BEGIN
#ifdef DBG_DUP_RMS
            rms_rows(H, IN(3) + layer * DM, XN, nullptr, NT, gw, NGW, lane);
#endif
            rms_rows(H, IN(3) + layer * DM, XN, nullptr, NT, gw, NGW, lane);
        PH_END
        PH_BEGIN
            { pg8::EpiBf E{QX, XAW, 0, nullptr, -1}; run_gemm(lds, XN, WQT, NT, XAW, DM / 2, E, DM, 0); }
            { pg8::EpiBf E{VT, XAW, 0, nullptr, -1}; run_gemm(lds, XN + DM / 2, WQT + DM / 2, NT, XAW, DM / 2, E, DM, G / 2); }
        PH_END
        PH_BEGIN
            for (int u = bid; u < NB * 4 * 16; u += G) { const int qb = u & 15, h = (u >> 4) & 3, b = u >> 6;
#ifndef NO_XATTN
                attn_unit<2>(lds, QX + (size_t)(b * SEQ) * XAW + h * 128, XAW, KVX + (size_t)(b * MEML) * 4096 + layer * 1024 + h * 128, 4096,
                             VTX + (size_t)((layer * NB + b) * 4 + h) * 128 * MEML, MEML, XO + (size_t)(b * SEQ) * XAW + h * 128, XAW, qb * 256, MEML, nullptr, 0.f, VT + (size_t)(b * SEQ) * XAW + h * 128);
#endif
            }
        PH_END
        PH_BEGIN
            pg8::EpiResid E{H, H, DM}; run_gemm(lds, XO, WOT, NT, DM, XAW, E);
        PH_END
        PH_BEGIN
#ifdef DBG_DUP_RMS
            rms_rows(H, IN(4) + layer * DM, XN, nullptr, NT, gw, NGW, lane);
#endif
            rms_rows(H, IN(4) + layer * DM, XN, nullptr, NT, gw, NGW, lane);
        PH_END
        PH_BEGIN
#ifndef DBG_SKIPMLP
            pg8::EpiBf E{PROJ, DFF, 1, nullptr, -1}; run_gemm(lds, XN, W1T, NT, DFF, DM, E);
#endif
        PH_END
        PH_BEGIN
#ifndef DBG_SKIPMLP
            pg8::EpiResid E{H, H, DM}; run_gemm(lds, PROJ, W2T, NT, DM, DFF, E);
#endif
        PH_END
    }
    PH_BEGIN
#ifdef DBG_OUTBUF
        { const bf16* src = (const bf16*)(ws + DBG_OUTBUF); for (size_t i = (size_t)bid * 512 + tid; i < (size_t)NT * DM; i += (size_t)G * 512) { const size_t t = i >> 11, c = i & 2047; float v = __uint_as_float((unsigned)src[t * DBG_OUTLD + DBG_OUTCOL + c] << 16);
#ifdef DBG_TWICE
            v -= __uint_as_float((unsigned)MIX[t * DM + c] << 16);
#endif
            args.out[i] = v; } }
#else
        rms_rows(H, IN(6), nullptr, args.out, NT, gw, NGW, lane);
#endif
    PH_END
#undef PH_BEGIN
#undef PH_END
}
#undef H
#undef XN
#undef PROJ
#undef MIX
#undef VT
#undef GB
#undef QX
#undef XO
#undef IN
#undef x_in

extern "C" void kernel_launch(void* const* d_in, const int* in_sizes, int n_in, void* d_out, int out_size, void* d_ws, size_t ws_size, hipStream_t stream) {
    static int grid = 0;
    if (grid == 0) {
        if (n_in != 27 || out_size != NT * DM || ws_size < WS_END) { fprintf(stderr, "kernel_launch: unexpected problem (n_in %d out %d ws %zu, need %zu)\n", n_in, out_size, ws_size, (size_t)WS_END); grid = -1; return; }
        int dev = 0, cus = 0, per_cu = 0;
        hipGetDevice(&dev); hipDeviceGetAttribute(&cus, hipDeviceAttributeMultiprocessorCount, dev);
        if (hipFuncSetAttribute((const void*)trunk_fwd, hipFuncAttributeMaxDynamicSharedMemorySize, LDS_BYTES) != hipSuccess) { fprintf(stderr, "kernel_launch: hipFuncSetAttribute failed\n"); grid = -1; return; }
        hipOccupancyMaxActiveBlocksPerMultiprocessor(&per_cu, (const void*)trunk_fwd, 512, LDS_BYTES);
        if (per_cu < 1) { fprintf(stderr, "kernel_launch: occupancy query says %d blocks/CU\n", per_cu); per_cu = 1; }
        (void)hipGetLastError();
        grid = cus * 1;
    }
    if (grid < 0) return;
    (void)hipMemsetAsync(d_ws, 0, 16384, stream);
    Args a{};
    for (int i = 0; i < 27; ++i) a.in[i] = (const float*)d_in[i];
    a.out = (float*)d_out; a.ws = (unsigned char*)d_ws;
#if MK_ONE_LAUNCH
    a.ph_lo = 0; a.ph_hi = N_PHASES;
    { void* kargs[] = {&a}; hipError_t e = hipLaunchCooperativeKernel((const void*)trunk_fwd, dim3(grid), dim3(512), kargs, LDS_BYTES, stream);
      if (e != hipSuccess) fprintf(stderr, "cooperative launch failed: %s (grid %d)\n", hipGetErrorString(e), grid); }
#else
    for (int p = 0; p < N_PHASES; ++p) { a.ph_lo = p; a.ph_hi = p + 1;
        void* kargs[] = {&a}; hipError_t e = hipLaunchCooperativeKernel((const void*)trunk_fwd, dim3(grid), dim3(512), kargs, LDS_BYTES, stream);
        if (e != hipSuccess) { fprintf(stderr, "launch %d failed: %s (grid %d)\n", p, hipGetErrorString(e), grid); break; } }
#endif
}
```

```cpp
#include <hip/hip_runtime.h>
#include <hip/hip_cooperative_groups.h>
#include <cstdio>
#include <cstdint>
namespace cg = cooperative_groups;
#ifndef PG8_AUX
#define PG8_AUX 0
#endif
namespace pg8 {
#define PG8_LAS __attribute__((address_space(3)))
typedef unsigned short bf16_t;
typedef short bf16x8 __attribute__((ext_vector_type(8)));
typedef float f32x4 __attribute__((ext_vector_type(4)));
typedef unsigned u32x4 __attribute__((ext_vector_type(4)));
constexpr int BM = 256, BK = 64, HALF = 128, HTB = HALF * BK * 2  , STAGE_BYTES = 8 * HTB, NXCD = 8, WGM = 8;

__host__ __device__ __forceinline__ int lds_byte(int r, int c) { const int st = (r >> 4) * 2 + (c >> 5), rr = r & 15, cc = c & 31, ob = rr * 64 + cc * 2; return st * 1024 + (ob ^ (((ob >> 9) & 1) << 5)); }
__host__ __device__ __forceinline__ void stage_rc(int b, int& R, int& C) { const int st = b / 1024, sb = b % 1024, swz = sb ^ (((sb >> 9) & 1) << 5); R = (st >> 1) * 16 + swz / 64; C = (st & 1) * 32 + (swz % 64) / 2; }
__host__ __device__ __forceinline__ int perm32(int rho) { const int n = rho >> 4, i = rho & 15; return 8 * (i >> 2) + 4 * n + (i & 3); }

struct Unit { int pm, pn; };
struct Gemm { const bf16_t* A; const bf16_t* Bt; int M, N, K; };

struct StaticOrder {
    int nM, nN, nwg, G, c;
    __host__ __device__ void init(int M, int N, int G_, int c_) { nM = M / BM; nN = N / BM; nwg = nM * nN; G = G_; c = c_; }
    __host__ __device__ bool next(int i, Unit& u) const {
        const long L = (long)i * G + c; if (L >= nwg) return false;
        int wgid = (int)L; { const int q = nwg / NXCD, r = nwg % NXCD, xcd = wgid % NXCD, off = wgid / NXCD; wgid = (xcd < r ? xcd * (q + 1) : r * (q + 1) + (xcd - r) * q) + off; }
        const int nig = WGM * nN, gid = wgid / nig, fm = gid * WGM, gsz = (nM - fm) < WGM ? (nM - fm) : WGM;
        u.pm = fm + ((wgid % nig) % gsz); u.pn = (wgid % nig) / gsz; return true;
    }
    __device__ __forceinline__ void a_ready(const Unit&) const {}
    __device__ __forceinline__ void done(const Unit&) const {}
};

__device__ __forceinline__ unsigned cvt_pk_bf16(float lo, float hi) { unsigned r; asm volatile("v_cvt_pk_bf16_f32 %0, %1, %2" : "=v"(r) : "v"(lo), "v"(hi)); return r; }
struct EpiBf {
    static constexpr bool PERM = true, AFTER_DRAIN = false;
    bf16_t* O; int ldc; int act; float* flog; int flog_tile; const float* ssq;
    __device__ __forceinline__ void operator()(const f32x4 (&acc)[2][2][4][2], const Unit& u, int wr, int wc, int fr, int fq) const {
        const int row0 = u.pm * BM + wr * 64 + fr;
        if (u.pn == flog_tile) {
            if (wc == 0 && fq == 0) {
#pragma unroll
                for (int ai = 0; ai < 2; ++ai)
#pragma unroll
                    for (int m = 0; m < 4; ++m) { float* p = flog + (size_t)(row0 + ai * HALF + m * 16) * 8; *(f32x4*)p = acc[ai][0][m][0]; *(f32x4*)(p + 4) = acc[ai][0][m][1]; }
            }
            return;
        }
        const int col0 = u.pn * BM + wc * 32 + 8 * fq;
#pragma unroll
        for (int ai = 0; ai < 2; ++ai)
#pragma unroll
            for (int m = 0; m < 4; ++m) { bf16_t* rowp = O + (size_t)(row0 + ai * HALF + m * 16) * ldc + col0;
                float rs = 1.f;
                if (ssq) { const f32x4* sp = (const f32x4*)(ssq + (size_t)(row0 + ai * HALF + m * 16) * 32) + fq * 2; const f32x4 a = sp[0], b = sp[1];
                    float s = ((a.x + a.y) + (a.z + a.w)) + ((b.x + b.y) + (b.z + b.w)); s += __shfl_xor(s, 16); s += __shfl_xor(s, 32); rs = rsqrtf(s * (1.f / 2048.f) + 1e-6f); }
#pragma unroll
                for (int bj = 0; bj < 2; ++bj) { f32x4 v0 = acc[ai][bj][m][0] * rs, v1 = acc[ai][bj][m][1] * rs;
                    if (act) {
#pragma unroll
                        for (int e = 0; e < 4; ++e) { float a = fmaxf(v0[e], 0.f), b = fmaxf(v1[e], 0.f); v0[e] = a * a; v1[e] = b * b; } }
                    u32x4 w; w.x = cvt_pk_bf16(v0[0], v0[1]); w.y = cvt_pk_bf16(v0[2], v0[3]); w.z = cvt_pk_bf16(v1[0], v1[1]); w.w = cvt_pk_bf16(v1[2], v1[3]);
                    *(u32x4*)(rowp + bj * HALF) = w; } }
    }
};
struct EpiResid {
    static constexpr bool PERM = true, AFTER_DRAIN = false;
    const float* base; float* out; int ldc; bf16_t* xb; float* ssq;
    __device__ __forceinline__ void operator()(const f32x4 (&acc)[2][2][4][2], const Unit& u, int wr, int wc, int fr, int fq) const {
        const int col0 = u.pn * BM + wc * 32 + 8 * fq;
#pragma unroll
        for (int ai = 0; ai < 2; ++ai)
#pragma unroll
            for (int m = 0; m < 4; ++m) { const int row = u.pm * BM + ai * HALF + wr * 64 + m * 16 + fr; const size_t off = (size_t)row * ldc + col0; float s = 0.f;
#pragma unroll
                for (int bj = 0; bj < 2; ++bj) { const f32x4 b0 = *(const f32x4*)(base + off + bj * HALF), b1 = *(const f32x4*)(base + off + bj * HALF + 4);
                    const f32x4 o0 = b0 + acc[ai][bj][m][0], o1 = b1 + acc[ai][bj][m][1];
                    *(f32x4*)(out + off + bj * HALF) = o0; *(f32x4*)(out + off + bj * HALF + 4) = o1;
                    if (xb) { s += ((o0.x * o0.x + o0.y * o0.y) + (o0.z * o0.z + o0.w * o0.w)) + ((o1.x * o1.x + o1.y * o1.y) + (o1.z * o1.z + o1.w * o1.w));
                        u32x4 w; w.x = cvt_pk_bf16(o0.x, o0.y); w.y = cvt_pk_bf16(o0.z, o0.w); w.z = cvt_pk_bf16(o1.x, o1.y); w.w = cvt_pk_bf16(o1.z, o1.w);
                        *(u32x4*)(xb + off + bj * HALF) = w; } }
                if (xb) { s += __shfl_xor(s, 16); s += __shfl_xor(s, 32); if (fq == 0) ssq[(size_t)row * 32 + u.pn * 4 + wc] = s; }
                asm volatile("" ::: "memory"); }
    }
};
struct EpiGlu {
    static constexpr bool PERM = true, AFTER_DRAIN = false;
    const bf16_t* Gm; int ldg; bf16_t* O; int ldc;
    __device__ __forceinline__ void operator()(const f32x4 (&acc)[2][2][4][2], const Unit& u, int wr, int wc, int fr, int fq) const {
        const int row0 = u.pm * BM + wr * 64 + fr, col0 = u.pn * BM + wc * 32 + 8 * fq;
#pragma unroll
        for (int ai = 0; ai < 2; ++ai)
#pragma unroll
            for (int m = 0; m < 4; ++m) { const size_t r = (size_t)(row0 + ai * HALF + m * 16);
#pragma unroll
                for (int bj = 0; bj < 2; ++bj) { const u32x4 gv = *(const u32x4*)(Gm + r * ldg + col0 + bj * HALF);
                    const f32x4 v0 = acc[ai][bj][m][0], v1 = acc[ai][bj][m][1]; float o[8];
#pragma unroll
                    for (int e = 0; e < 4; ++e) { const unsigned w = gv[e]; const float g0 = __uint_as_float(w << 16), g1 = __uint_as_float(w & 0xffff0000u);
                        const float a0 = (e < 2) ? v0[2 * e] : v1[2 * e - 4], a1 = (e < 2) ? v0[2 * e + 1] : v1[2 * e - 3];
                        o[2 * e] = g0 / (1.f + __expf(-a0)); o[2 * e + 1] = g1 / (1.f + __expf(-a1)); }
                    u32x4 w; w.x = cvt_pk_bf16(o[0], o[1]); w.y = cvt_pk_bf16(o[2], o[3]); w.z = cvt_pk_bf16(o[4], o[5]); w.w = cvt_pk_bf16(o[6], o[7]);
                    *(u32x4*)(O + r * ldc + col0 + bj * HALF) = w; }
                asm volatile("" ::: "memory"); }
    }
};
template <class Epi, class Sched, bool ALIGN_EPI = false, bool SP2 = false>
__device__ __forceinline__ void gemm_phase(PG8_LAS unsigned char* lds, const Gemm g, const Sched& S, const Epi& E) {
    int tid_ = threadIdx.x; asm volatile("" : "+v"(tid_));
    const int tid = tid_, wid = __builtin_amdgcn_readfirstlane(tid >> 6), lane = tid & 63, wr = wid >> 2, wc = wid & 3, fr = lane & 15, fq = lane >> 4;
    const int K = g.K, nt = K / BK;
    unsigned voffA[2], voffB[2];
#pragma unroll
    for (int i = 0; i < 2; ++i) { int R, C; stage_rc(tid * 16 + i * 8192, R, C); const int Rb = Epi::PERM ? ((R & ~31) + perm32(R & 31)) : R;
        voffA[i] = (unsigned)(R * K + C) * 2u; voffB[i] = (unsigned)(Rb * K + C) * 2u; }
    const size_t kstep = (size_t)(BK * 2);
    const size_t hstep = (size_t)HALF * K * 2;
    const size_t tstep = 2 * hstep;
    const unsigned ldsw = (unsigned)wid * 1024u;
    const int aoff = lds_byte(wr * 64 + fr, fq * 8), boff = lds_byte(wc * 32 + fr, fq * 8);
#define PG8_SA(b, h) (((b) * 2 + (h)) * HTB)
#define PG8_SB(b, h) ((4 + (b) * 2 + (h)) * HTB)
#define PG8_STAGE(bufoff, gbase, voff) do { _Pragma("unroll") for (int _i = 0; _i < 2; ++_i) \
        __builtin_amdgcn_global_load_lds((const unsigned*)((const char*)(gbase) + (voff)[_i]), (PG8_LAS unsigned*)(lds + (bufoff) + ldsw + _i * 8192), 16, 0, PG8_AUX); } while (0)
#define PG8_LDA(dst, b, h) do { _Pragma("unroll") for (int m = 0; m < 4; ++m) _Pragma("unroll") for (int k = 0; k < 2; ++k) dst[m][k] = *(const PG8_LAS bf16x8*)(lds + PG8_SA(b, h) + aoff + m * 2048 + k * 1024); } while (0)
#define PG8_LDB(dst, b, h) do { _Pragma("unroll") for (int n = 0; n < 2; ++n) _Pragma("unroll") for (int k = 0; k < 2; ++k) dst[n][k] = *(const PG8_LAS bf16x8*)(lds + PG8_SB(b, h) + boff + n * 2048 + k * 1024); } while (0)
#define PG8_MMA(ai, bj, At, Bt) do { __builtin_amdgcn_s_setprio(1); _Pragma("unroll") for (int m = 0; m < 4; ++m) _Pragma("unroll") for (int n = 0; n < 2; ++n) _Pragma("unroll") for (int k = 0; k < 2; ++k) \
        acc[ai][bj][m][n] = __builtin_amdgcn_mfma_f32_16x16x32_bf16(Bt[n][k], At[m][k], acc[ai][bj][m][n], 0, 0, 0); __builtin_amdgcn_s_setprio(0); } while (0)
#ifdef DBG_DRAIN
#define PG8_WAIT_V(n) asm volatile("s_waitcnt vmcnt(0)" ::: "memory")
#else
#define PG8_WAIT_V(n) asm volatile("s_waitcnt vmcnt(" #n ")" ::: "memory")
#endif
#define PG8_WAIT_L(n) asm volatile("s_waitcnt lgkmcnt(" #n ")" ::: "memory")
#define PG8_BAR __builtin_amdgcn_s_barrier()
#define PG8_SCHED __builtin_amdgcn_sched_barrier(0)
    Unit cur, nxt; int ui = 0;
    if (!S.next(0, cur)) return;
    f32x4 acc[2][2][4][2];
#pragma unroll
    for (int a = 0; a < 2; ++a)
#pragma unroll
        for (int b = 0; b < 2; ++b)
#pragma unroll
            for (int m = 0; m < 4; ++m)
#pragma unroll
                for (int n = 0; n < 2; ++n) acc[a][b][m][n] = (f32x4){0.f, 0.f, 0.f, 0.f};
    bf16x8 At[4][2], B0[2][2], B1[2][2];
    const char* cA = (const char*)g.A + (size_t)cur.pm * tstep; const char* cB = (const char*)g.Bt + (size_t)cur.pn * tstep;
    S.a_ready(cur);
    if constexpr (SP2) {
        PG8_STAGE(PG8_SB(0, 0), cB, voffB); PG8_STAGE(PG8_SB(0, 1), cB + hstep, voffB); PG8_STAGE(PG8_SA(0, 0), cA, voffA); PG8_STAGE(PG8_SA(0, 1), cA + hstep, voffA);
        if (wr == 1) PG8_BAR;
        PG8_WAIT_V(2); PG8_BAR;
        PG8_STAGE(PG8_SB(1, 0), cB + kstep, voffB); PG8_STAGE(PG8_SA(1, 0), cA + kstep, voffA); PG8_STAGE(PG8_SB(1, 1), cB + hstep + kstep, voffB);
        PG8_WAIT_V(6); PG8_BAR;
    } else {
        PG8_STAGE(PG8_SB(0, 0), cB, voffB); PG8_STAGE(PG8_SA(0, 0), cA, voffA); PG8_STAGE(PG8_SB(0, 1), cB + hstep, voffB); PG8_STAGE(PG8_SA(0, 1), cA + hstep, voffA);
        if (wr == 1) PG8_BAR;
        PG8_WAIT_V(4); PG8_BAR;
        PG8_STAGE(PG8_SB(1, 0), cB + kstep, voffB); PG8_STAGE(PG8_SA(1, 0), cA + kstep, voffA); PG8_STAGE(PG8_SB(1, 1), cB + hstep + kstep, voffB);
        PG8_WAIT_V(6); PG8_BAR;
    }
    for (;;) {
        const bool has_next = S.next(ui + 1, nxt);
        const char* nA = has_next ? (const char*)g.A + (size_t)nxt.pm * tstep : cA; const char* nB = has_next ? (const char*)g.Bt + (size_t)nxt.pn * tstep : cB;
        for (int t = 0; t < nt; t += 2) {
            const bool last = (t == nt - 2);
            const char* a1 = cA + (size_t)(t + 1) * kstep;
            const char* a2 = last ? nA : cA + (size_t)(t + 2) * kstep; const char* b2 = last ? nB : cB + (size_t)(t + 2) * kstep;
            const char* a3 = a2 + kstep; const char* b3 = b2 + kstep;
            if (last && has_next) S.a_ready(nxt);
            if constexpr (SP2) {
            PG8_LDB(B0, 0, 0); PG8_LDB(B1, 0, 1); PG8_SCHED; PG8_LDA(At, 0, 0); PG8_STAGE(PG8_SA(1, 1), a1 + hstep, voffA);
            PG8_WAIT_V(8); PG8_WAIT_L(0); PG8_BAR; PG8_MMA(0, 0, At, B0); PG8_MMA(0, 1, At, B1); PG8_BAR; PG8_SCHED;
            PG8_LDA(At, 0, 1); PG8_STAGE(PG8_SB(0, 0), b2, voffB); PG8_STAGE(PG8_SB(0, 1), b2 + hstep, voffB); PG8_STAGE(PG8_SA(0, 0), a2, voffA);
            PG8_WAIT_V(8); PG8_WAIT_L(0); PG8_BAR; PG8_MMA(1, 0, At, B0); PG8_MMA(1, 1, At, B1); PG8_BAR; PG8_SCHED;
            PG8_LDB(B0, 1, 0); PG8_LDB(B1, 1, 1); PG8_SCHED; PG8_LDA(At, 1, 0); PG8_STAGE(PG8_SA(0, 1), a2 + hstep, voffA);
            PG8_WAIT_V(8); PG8_WAIT_L(0); PG8_BAR; PG8_MMA(0, 0, At, B0); PG8_MMA(0, 1, At, B1); PG8_BAR; PG8_SCHED;
            PG8_LDA(At, 1, 1); PG8_STAGE(PG8_SB(1, 0), b3, voffB); PG8_STAGE(PG8_SB(1, 1), b3 + hstep, voffB); PG8_STAGE(PG8_SA(1, 0), a3, voffA);
            PG8_WAIT_V(8); PG8_WAIT_L(0); PG8_BAR; PG8_MMA(1, 0, At, B0); PG8_MMA(1, 1, At, B1); PG8_BAR; PG8_SCHED;
            } else {
            PG8_LDB(B0, 0, 0); PG8_SCHED; PG8_LDA(At, 0, 0); PG8_STAGE(PG8_SA(1, 1), a1 + hstep, voffA);
            PG8_WAIT_L(8); PG8_BAR; PG8_WAIT_L(0); PG8_MMA(0, 0, At, B0); PG8_BAR; PG8_SCHED;
            PG8_LDB(B1, 0, 1); PG8_STAGE(PG8_SB(0, 0), b2, voffB);
            PG8_BAR; PG8_WAIT_L(0); PG8_MMA(0, 1, At, B1); PG8_BAR;
            PG8_LDA(At, 0, 1); PG8_STAGE(PG8_SA(0, 0), a2, voffA);
            PG8_BAR; PG8_WAIT_L(0); PG8_MMA(1, 0, At, B0); PG8_BAR; PG8_SCHED;
            PG8_STAGE(PG8_SB(0, 1), b2 + hstep, voffB);
            PG8_WAIT_V(6); PG8_BAR; PG8_MMA(1, 1, At, B1); PG8_BAR;
            PG8_LDB(B0, 1, 0); PG8_SCHED; PG8_LDA(At, 1, 0); PG8_STAGE(PG8_SA(0, 1), a2 + hstep, voffA);
            PG8_WAIT_L(8); PG8_BAR; PG8_WAIT_L(0); PG8_MMA(0, 0, At, B0); PG8_BAR; PG8_SCHED;
            PG8_LDB(B1, 1, 1); PG8_STAGE(PG8_SB(1, 0), b3, voffB);
            PG8_BAR; PG8_WAIT_L(0); PG8_MMA(0, 1, At, B1); PG8_BAR;
            PG8_LDA(At, 1, 1); PG8_STAGE(PG8_SA(1, 0), a3, voffA);
            PG8_BAR; PG8_WAIT_L(0); PG8_MMA(1, 0, At, B0); PG8_BAR; PG8_SCHED;
            PG8_STAGE(PG8_SB(1, 1), b3 + hstep, voffB);
            PG8_WAIT_V(6); PG8_BAR; PG8_MMA(1, 1, At, B1); PG8_BAR;
            }
        }
        if constexpr (ALIGN_EPI) { if (wr == 0) PG8_BAR; }
        if constexpr (!Epi::AFTER_DRAIN) { E(acc, cur, wr, wc, fr, fq); S.done(cur); }
        if (!has_next) break;
#pragma unroll
        for (int a = 0; a < 2; ++a)
#pragma unroll
            for (int b = 0; b < 2; ++b)
#pragma unroll
                for (int m = 0; m < 4; ++m)
#pragma unroll
                    for (int n = 0; n < 2; ++n) acc[a][b][m][n] = (f32x4){0.f, 0.f, 0.f, 0.f};
        cur = nxt; cA = nA; cB = nB; ++ui;
        if constexpr (ALIGN_EPI) { if (wr == 1) PG8_BAR; }
    }
    PG8_WAIT_V(0);
    if constexpr (!ALIGN_EPI) { if (wr == 0) PG8_BAR; }
    PG8_BAR;
    if constexpr (Epi::AFTER_DRAIN) { E.fused(acc, cur, wr, wc, fr, fq, lds, wid, lane); S.done(cur); }
#undef PG8_SA
#undef PG8_SB
#undef PG8_STAGE
#undef PG8_LDA
#undef PG8_LDB
#undef PG8_MMA
#undef PG8_WAIT_V
#undef PG8_WAIT_L
#undef PG8_BAR
#undef PG8_SCHED
}
}
#ifndef MK_ONE_LAUNCH
#define MK_ONE_LAUNCH 1
#endif
#define LAS __attribute__((address_space(3)))
typedef unsigned short bf16;
typedef short bf16x8 __attribute__((ext_vector_type(8)));
typedef short bf16x4 __attribute__((ext_vector_type(4)));
typedef float f32x4 __attribute__((ext_vector_type(4)));
typedef unsigned u32x4 __attribute__((ext_vector_type(4)));
typedef unsigned u32x2 __attribute__((ext_vector_type(2)));

constexpr int NB = 4, SEQ = 4096, DM = 2048, NT = NB * SEQ, DEPTH = 4;
constexpr int EVEN_IN = 7176, EVEN_N = 7168, EVEN_LD = 7168, ODD_IN = 4096, DFF = 8192, XAW = 512, MEML = 256;
constexpr float EPS = 1e-6f;
constexpr float LOG2E = 1.4426950408889634f;
constexpr float QK_SCALE = 0.08838834764831845f;

constexpr size_t MiB = 1u << 20;
constexpr size_t WS_H = 1 * MiB;
constexpr size_t WS_XN = WS_H + 128 * MiB;
constexpr size_t WS_PROJ = WS_XN + 64 * MiB;
constexpr size_t WS_MIX = WS_PROJ + 256 * MiB;
constexpr size_t WS_VT = WS_MIX + 64 * MiB;
constexpr size_t WS_QX = WS_VT + 64 * MiB;
constexpr size_t WS_XO = WS_QX + 16 * MiB;
constexpr size_t WS_FLOG = WS_XO + 16 * MiB;
constexpr size_t WS_C2 = WS_FLOG + 1 * MiB;
constexpr size_t WS_MEMN = WS_C2 + 1 * MiB;
constexpr size_t WS_KVX = WS_MEMN + 4 * MiB;
constexpr size_t WS_VTX = WS_KVX + 8 * MiB;
constexpr size_t WS_ROPE = WS_VTX + 4 * MiB;
constexpr size_t WS_WKVT = WS_ROPE + 2 * MiB;
constexpr size_t WS_WINT = WS_WKVT + 16 * MiB;
constexpr size_t WS_WOUTT = WS_WINT + 30 * MiB;
constexpr size_t WS_WQT = WS_WOUTT + 8 * MiB;
constexpr size_t WS_WOT = WS_WQT + 2 * MiB;
constexpr size_t WS_W1T = WS_WOT + 2 * MiB;
constexpr size_t WS_W2T = WS_W1T + 32 * MiB;
constexpr size_t WS_WGLUT = WS_W2T + 32 * MiB;
constexpr size_t WS_SSQ = WS_WGLUT + 2 * MiB;
constexpr size_t WS_END = WS_SSQ + 2 * MiB;

constexpr int LDS_BYTES = 147456;

__device__ __forceinline__ unsigned f2bf(float f) { unsigned u = __builtin_bit_cast(unsigned, f); return (u + 0x7fffu + ((u >> 16) & 1u)) >> 16; }
__device__ __forceinline__ unsigned pk2(float lo, float hi) { unsigned r; asm("v_cvt_pk_bf16_f32 %0, %1, %2" : "=v"(r) : "v"(lo), "v"(hi)); return r; }
__device__ __forceinline__ float bflo(unsigned w) { return __uint_as_float(w << 16); }
__device__ __forceinline__ float bfhi(unsigned w) { return __uint_as_float(w & 0xffff0000u); }
__device__ __forceinline__ float wave_sum(float v) {
#pragma unroll
    for (int o = 1; o < 64; o <<= 1) v += __shfl_xor(v, o);
    return v;
}
#define LDS_FENCE() do { asm volatile("s_waitcnt lgkmcnt(0)" ::: "memory"); __builtin_amdgcn_wave_barrier(); } while (0)

struct Args { const float* in[27]; float* out; unsigned char* ws; int ph_lo, ph_hi; };

__device__ __forceinline__ void tr_load(f32x4 (&v)[8], const float* __restrict__ W, int ldw, int col0, int k0, int lane) {
#pragma unroll
    for (int i = 0; i < 8; ++i) v[i] = __builtin_nontemporal_load((const f32x4*)(W + (size_t)(k0 + i * 8 + (lane >> 3)) * ldw + col0 + 4 * (lane & 7)));
}
__device__ __forceinline__ void tr_store(const f32x4 (&v)[8], int K, bf16* __restrict__ WT, int drow0, int k0, LAS float* scr, int lane, const float* __restrict__ gain) {
    const int c4 = lane & 7, r8 = lane >> 3;
#pragma unroll
    for (int i = 0; i < 8; ++i) { const float gk = gain ? gain[k0 + i * 8 + r8] : 1.f; LAS float* d = scr + (i * 8 + r8) * 33 + 4 * c4; d[0] = v[i].x * gk; d[1] = v[i].y * gk; d[2] = v[i].z * gk; d[3] = v[i].w * gk; }
    LDS_FENCE();
    const int c = lane & 7;
#pragma unroll
    for (int j = 0; j < 4; ++j) { const int n = (lane >> 3) + 8 * j; const LAS float* s = scr + (8 * c) * 33 + n;
        u32x4 o; o.x = pk2(s[0 * 33], s[1 * 33]); o.y = pk2(s[2 * 33], s[3 * 33]); o.z = pk2(s[4 * 33], s[5 * 33]); o.w = pk2(s[6 * 33], s[7 * 33]);
        *(u32x4*)(WT + (size_t)(drow0 + n) * K + k0 + 8 * c) = o; }
    LDS_FENCE();
}
__device__ __forceinline__ void tr_matrix(const float* W, int ldw, int K, int col_off, int ncols, bf16* WT, int row_off, LAS float* scr, int gw, int NGW, int lane, int& base, const float* gain = nullptr) {
    const int nblk = ncols / 32, nitems = (K / 64) * nblk;
    int it = gw - (base % NGW); if (it < 0) it += NGW;
    base += nitems;
    f32x4 cur[8];
    if (it < nitems) { const int kb = it / nblk, nb = it - kb * nblk; tr_load(cur, W, ldw, col_off + 32 * nb, 64 * kb, lane); }
    while (it < nitems) {
        const int kb = it / nblk, nb = it - kb * nblk, nx = it + NGW;
        f32x4 nxt[8];
        if (nx < nitems) { const int kb2 = nx / nblk, nb2 = nx - kb2 * nblk; tr_load(nxt, W, ldw, col_off + 32 * nb2, 64 * kb2, lane); }
        tr_store(cur, K, WT, row_off + 32 * nb, 64 * kb, scr, lane, gain);
#pragma unroll
        for (int i = 0; i < 8; ++i) cur[i] = nxt[i];
        it = nx;
    }
}
__device__ __forceinline__ void rms_row(const float* __restrict__ xrow, const float* __restrict__ gain, bf16* orow, float* of32, const LAS f32x4* wfl, float* fl, int lane) {
    const f32x4* xr = (const f32x4*)xrow + lane; const f32x4* gr = (const f32x4*)gain + lane;
    f32x4 v[8]; float s = 0.f;
#pragma unroll
    for (int j = 0; j < 8; ++j) { v[j] = xr[64 * j]; s += (v[j].x * v[j].x + v[j].y * v[j].y) + (v[j].z * v[j].z + v[j].w * v[j].w); }
    const float r = rsqrtf(wave_sum(s) * (1.f / DM) + EPS);
#pragma unroll
    for (int j = 0; j < 8; ++j) v[j] = v[j] * r * gr[64 * j];
    if (of32) {
#pragma unroll
        for (int j = 0; j < 8; ++j) ((f32x4*)of32 + lane)[64 * j] = v[j];
    } else {
        u32x2* o8 = (u32x2*)orow + lane;
#pragma unroll
        for (int j = 0; j < 8; ++j) { u32x2 w; w.x = pk2(v[j].x, v[j].y); w.y = pk2(v[j].z, v[j].w); o8[64 * j] = w; }
    }
    if (fl) {
        f32x4 p0 = (f32x4){0.f, 0.f, 0.f, 0.f}, p1 = (f32x4){0.f, 0.f, 0.f, 0.f};
#pragma unroll
        for (int j = 0; j < 8; ++j)
#pragma unroll
            for (int e = 0; e < 4; ++e) { const f32x4 w0 = wfl[((j * 4 + e) * 2 + 0) * 64 + lane], w1 = wfl[((j * 4 + e) * 2 + 1) * 64 + lane]; p0 += w0 * v[j][e]; p1 += w1 * v[j][e]; }
#pragma unroll
        for (int e = 0; e < 4; ++e) { p0[e] = wave_sum(p0[e]); p1[e] = wave_sum(p1[e]); }
        if (lane == 0) { *(f32x4*)fl = p0; *(f32x4*)(fl + 4) = p1; }
    }
}
__device__ __forceinline__ void rms_rows(const float* X, const float* gain, bf16* O, float* OF, int nrows, int gw, int NGW, int lane, const LAS f32x4* wfl = nullptr, float* FL = nullptr) {
    for (int m = gw; m < nrows; m += NGW) rms_row(X + (size_t)m * DM, gain, O ? O + (size_t)m * DM : nullptr, OF ? OF + (size_t)m * DM : nullptr, wfl, FL ? FL + (size_t)m * 8 : nullptr, lane);
}

__device__ __forceinline__ void tr_bf16_64x64(const bf16* __restrict__ src, size_t lds_, bf16* __restrict__ dst, size_t ldd, LAS unsigned char* scr, int lane) {
#pragma unroll
    for (int i = 0; i < 8; ++i) { const int id = i * 64 + lane, r = id >> 3, ch = id & 7;
        const u32x4 v = *(const u32x4*)(src + (size_t)r * lds_ + ch * 8);
#pragma unroll
        for (int e = 0; e < 4; ++e) { const unsigned w = v[e]; const int c = ch * 8 + 2 * e;
            *(LAS unsigned short*)(scr + c * 144 + r * 2) = (unsigned short)(w & 0xffffu); *(LAS unsigned short*)(scr + (c + 1) * 144 + r * 2) = (unsigned short)(w >> 16); } }
    LDS_FENCE();
#pragma unroll
    for (int i = 0; i < 8; ++i) { const int id = i * 64 + lane, c = id >> 3, ch = id & 7;
        const u32x4 v = *(const LAS u32x4*)(scr + c * 144 + ch * 16);
        *(u32x4*)(dst + (size_t)c * ldd + ch * 8) = v; }
    LDS_FENCE();
}
constexpr int AT_KP = 272, AT_VP = 144, AT_KB = 64 * AT_KP, AT_VB = 128 * AT_VP;
constexpr int AT_VOFF = 2 * AT_KB;
template <int MODE>
__device__ __forceinline__ void attn_unit(LAS unsigned char* lds, const bf16* __restrict__ Qp, int ldq, const bf16* __restrict__ Kp, int ldk, const bf16* __restrict__ VTp, int ldvt,
                                          bf16* __restrict__ Op, int ldo, int q0, int nkeys, const float* __restrict__ c2, float l2g, const bf16* __restrict__ gate) {
    int tid_ = threadIdx.x; asm volatile("" : "+v"(tid_));
    const int tid = tid_, w = __builtin_amdgcn_readfirstlane(tid >> 6), lane = tid & 63, g4 = lane >> 4, c16 = lane & 15;
    const int ntiles = (MODE == 2) ? (nkeys >> 6) : ((q0 + 256) >> 6);
    const int qw0 = q0 + w * 32;
    const int tmax = (MODE == 2) ? ntiles - 1 : ((qw0 + 31) >> 6);
    __syncthreads();
    bf16x8 qf[2][4];
#pragma unroll
    for (int qs = 0; qs < 2; ++qs)
#pragma unroll
        for (int dk = 0; dk < 4; ++dk) qf[qs][dk] = *(const bf16x8*)(Qp + (size_t)(qw0 + qs * 16 + c16) * ldq + dk * 32 + g4 * 8);
    f32x4 dkf[4];
    if (MODE == 1) {
#pragma unroll
        for (int kb = 0; kb < 4; ++kb)
#pragma unroll
            for (int j = 0; j < 4; ++j) dkf[kb][j] = __builtin_amdgcn_exp2f(-l2g * (float)(kb * 16 + g4 * 4 + j));
    }
    const int kr0 = tid >> 4, kc = tid & 15;
    const int vr0 = tid >> 3, vc = tid & 7;
    u32x4 kreg[2], vreg[2];
#define AT_LOAD(t) do { \
        kreg[0] = *(const u32x4*)(Kp + (size_t)((t) * 64 + kr0) * ldk + kc * 8); kreg[1] = *(const u32x4*)(Kp + (size_t)((t) * 64 + kr0 + 32) * ldk + kc * 8); \
        vreg[0] = *(const u32x4*)(VTp + (size_t)vr0 * ldvt + (t) * 64 + vc * 8); vreg[1] = *(const u32x4*)(VTp + (size_t)(vr0 + 64) * ldvt + (t) * 64 + vc * 8); } while (0)
#define AT_STORE(b) do { \
        *(LAS u32x4*)(lds + (b) * AT_KB + kr0 * AT_KP + kc * 16) = kreg[0]; *(LAS u32x4*)(lds + (b) * AT_KB + (kr0 + 32) * AT_KP + kc * 16) = kreg[1]; \
        *(LAS u32x4*)(lds + AT_VOFF + (b) * AT_VB + vr0 * AT_VP + vc * 16) = vreg[0]; *(LAS u32x4*)(lds + AT_VOFF + (b) * AT_VB + (vr0 + 64) * AT_VP + vc * 16) = vreg[1]; } while (0)
    f32x4 O[8][2];
#pragma unroll
    for (int db = 0; db < 8; ++db) { O[db][0] = (f32x4){0.f, 0.f, 0.f, 0.f}; O[db][1] = (f32x4){0.f, 0.f, 0.f, 0.f}; }
    float mrun[2] = {-INFINITY, -INFINITY}, lsum[2] = {0.f, 0.f};
    AT_LOAD(0); AT_STORE(0);
    __syncthreads();
    for (int t = 0; t < ntiles; ++t) {
        const int cur = t & 1;
        if (t + 1 < ntiles) AT_LOAD(t + 1);
        if (t <= tmax) {
            const LAS unsigned char* Ks = lds + cur * AT_KB; const LAS unsigned char* Vs = lds + AT_VOFF + cur * AT_VB;
            f32x4 S[4][2];
#pragma unroll
            for (int kb = 0; kb < 4; ++kb) { S[kb][0] = (f32x4){0.f, 0.f, 0.f, 0.f}; S[kb][1] = (f32x4){0.f, 0.f, 0.f, 0.f};
#pragma unroll
                for (int dk = 0; dk < 4; ++dk) { const bf16x8 kf = *(const LAS bf16x8*)(Ks + (kb * 16 + c16) * AT_KP + dk * 64 + g4 * 16);
                    S[kb][0] = __builtin_amdgcn_mfma_f32_16x16x32_bf16(kf, qf[0][dk], S[kb][0], 0, 0, 0);
                    S[kb][1] = __builtin_amdgcn_mfma_f32_16x16x32_bf16(kf, qf[1][dk], S[kb][1], 0, 0, 0); } }
            const int kbase = t * 64 + g4 * 4;
            const bool diag = (MODE != 2) && (t * 64 + 63 > qw0);
            if (MODE == 1) {
#pragma unroll
                for (int qs = 0; qs < 2; ++qs) { const int qpos = qw0 + qs * 16 + c16;
                    const float dq = __builtin_amdgcn_exp2f(l2g * (float)(qpos - t * 64));
#pragma unroll
                    for (int kb = 0; kb < 4; ++kb)
#pragma unroll
                        for (int j = 0; j < 4; ++j) { float p = (S[kb][qs][j] * dq) * dkf[kb][j];
                            if (diag && (kbase + kb * 16 + j > qpos)) p = 0.f;
                            S[kb][qs][j] = p; } }
            } else {
                f32x4 ck[4];
                if (MODE == 0) {
#pragma unroll
                    for (int kb = 0; kb < 4; ++kb) ck[kb] = *(const f32x4*)(c2 + kbase + kb * 16);
                }
#pragma unroll
                for (int qs = 0; qs < 2; ++qs) { const int qpos = qw0 + qs * 16 + c16; float mx = -INFINITY;
#pragma unroll
                    for (int kb = 0; kb < 4; ++kb)
#pragma unroll
                        for (int j = 0; j < 4; ++j) { float s = S[kb][qs][j] * (QK_SCALE * LOG2E);
                            if (MODE == 0) { s -= ck[kb][j]; if (diag && (kbase + kb * 16 + j > qpos)) s = -INFINITY; }
                            S[kb][qs][j] = s; mx = fmaxf(mx, s); }
                    mx = fmaxf(mx, __shfl_xor(mx, 16)); mx = fmaxf(mx, __shfl_xor(mx, 32));
                    const float mnew = fmaxf(mrun[qs], mx);
                    const float alpha = __builtin_amdgcn_exp2f(mrun[qs] - mnew);
                    mrun[qs] = mnew; float ps = 0.f;
#pragma unroll
                    for (int kb = 0; kb < 4; ++kb)
#pragma unroll
                        for (int j = 0; j < 4; ++j) { const float p = __builtin_amdgcn_exp2f(S[kb][qs][j] - mnew); S[kb][qs][j] = p; ps += p; }
                    lsum[qs] = lsum[qs] * alpha + ps;
#pragma unroll
                    for (int db = 0; db < 8; ++db) O[db][qs] = O[db][qs] * alpha; }
            }
#pragma unroll
            for (int k2 = 0; k2 < 2; ++k2) {
                bf16x8 pb[2];
#pragma unroll
                for (int qs = 0; qs < 2; ++qs) { u32x4 pw; pw.x = pk2(S[2 * k2][qs][0], S[2 * k2][qs][1]); pw.y = pk2(S[2 * k2][qs][2], S[2 * k2][qs][3]);
                    pw.z = pk2(S[2 * k2 + 1][qs][0], S[2 * k2 + 1][qs][1]); pw.w = pk2(S[2 * k2 + 1][qs][2], S[2 * k2 + 1][qs][3]); pb[qs] = __builtin_bit_cast(bf16x8, pw); }
#pragma unroll
                for (int db = 0; db < 8; ++db) { const LAS unsigned char* vp = Vs + (db * 16 + c16) * AT_VP + k2 * 64 + g4 * 8;
                    const u32x2 v0 = *(const LAS u32x2*)vp, v1 = *(const LAS u32x2*)(vp + 32);
                    u32x4 vw; vw.x = v0.x; vw.y = v0.y; vw.z = v1.x; vw.w = v1.y; const bf16x8 vf = __builtin_bit_cast(bf16x8, vw);
                    O[db][0] = __builtin_amdgcn_mfma_f32_16x16x32_bf16(vf, pb[0], O[db][0], 0, 0, 0);
                    O[db][1] = __builtin_amdgcn_mfma_f32_16x16x32_bf16(vf, pb[1], O[db][1], 0, 0, 0); }
            }
        }
        if (t + 1 < ntiles) AT_STORE(cur ^ 1);
        __syncthreads();
    }
#undef AT_LOAD
#undef AT_STORE
#pragma unroll
    for (int qs = 0; qs < 2; ++qs) {
        if (MODE == 1) {
            float s = 0.f;
#pragma unroll
            for (int db = 0; db < 8; ++db) s += (O[db][qs][0] + O[db][qs][1]) + (O[db][qs][2] + O[db][qs][3]);
            s += __shfl_xor(s, 16); s += __shfl_xor(s, 32);
            const float mu = s * (1.f / 128.f); float q = 0.f;
#pragma unroll
            for (int db = 0; db < 8; ++db) { O[db][qs] = O[db][qs] - mu; q += (O[db][qs][0] * O[db][qs][0] + O[db][qs][1] * O[db][qs][1]) + (O[db][qs][2] * O[db][qs][2] + O[db][qs][3] * O[db][qs][3]); }
            q += __shfl_xor(q, 16); q += __shfl_xor(q, 32);
            const float rs = rsqrtf(q * (1.f / 128.f) + EPS);
#pragma unroll
            for (int db = 0; db < 8; ++db) O[db][qs] = O[db][qs] * rs;
        } else {
            float l = lsum[qs]; l += __shfl_xor(l, 16); l += __shfl_xor(l, 32);
            const float inv = 1.f / l;
#pragma unroll
            for (int db = 0; db < 8; ++db) O[db][qs] = O[db][qs] * inv;
        }
    }
    LAS unsigned char* Os = lds + w * (32 * AT_KP);
#pragma unroll
    for (int qs = 0; qs < 2; ++qs)
#pragma unroll
        for (int db = 0; db < 8; ++db) { u32x2 wv; wv.x = pk2(O[db][qs][0], O[db][qs][1]); wv.y = pk2(O[db][qs][2], O[db][qs][3]);
            *(LAS u32x2*)(Os + (qs * 16 + c16) * AT_KP + (db * 16 + g4 * 4) * 2) = wv; }
    LDS_FENCE();
#pragma unroll
    for (int i = 0; i < 8; ++i) { const int id = i * 64 + lane, r = id >> 4, ch = id & 15;
        u32x4 v = *(const LAS u32x4*)(Os + r * AT_KP + ch * 16);
        if (MODE == 1) { const u32x4 gv = *(const u32x4*)(gate + (size_t)(qw0 + r) * ldq + ch * 8);
#pragma unroll
            for (int e = 0; e < 4; ++e) { const float g0 = bflo(gv[e]), g1 = bfhi(gv[e]);
                const float o0 = bflo(v[e]) * (g0 / (1.f + __expf(-g0))), o1 = bfhi(v[e]) * (g1 / (1.f + __expf(-g1))); v[e] = pk2(o0, o1); } }
        *(u32x4*)(Op + (size_t)(qw0 + r) * ldo + ch * 8) = v; }
}
constexpr int S5_BUP = 80;
constexpr int S5_WAVE = 128 * S5_BUP + 16 * 272;
constexpr int S5_XCH = 8 * S5_WAVE;
struct S5P { const float *a_re, *a_im, *b_re, *b_im, *c_re, *c_im, *dsk, *lstep; };
__device__ __forceinline__ void s5_abar(const S5P& P, int g, int p, float& ar, float& ai, float& cr, float& ci) {
    const float lr = fminf(P.a_re[g * 64 + p], -1e-4f), li = P.a_im[g * 64 + p], st = __expf(P.lstep[g * 64 + p]);
    const float zr = lr * st, zi = li * st, mag = __expf(zr);
    const float rev = zi * 0.15915494309189535f; const float fr = rev - floorf(rev);
    ar = mag * __builtin_amdgcn_cosf(fr); ai = mag * __builtin_amdgcn_sinf(fr);
    const float nr = ar - 1.f, ni = ai, den = 1.f / (lr * lr + li * li);
    cr = (nr * lr + ni * li) * den; ci = (ni * lr - nr * li) * den;
}
__device__ __forceinline__ float gelu_tanh(float y) {
    const float u = 0.7978845608028654f * (y + 0.044715f * y * y * y);
    const float t = __builtin_amdgcn_exp2f(u * (2.f * LOG2E));
    const float th = 1.f - 2.f / (t + 1.f);
    return 0.5f * y * (1.f + th);
}
__device__ __forceinline__ void s5_unit(LAS unsigned char* lds, int b, int g, const bf16* __restrict__ PROJ, bf16* __restrict__ GB, const S5P& P) {
    int tid_ = threadIdx.x; asm volatile("" : "+v"(tid_));
    const int tid = tid_, w = __builtin_amdgcn_readfirstlane(tid >> 6), lane = tid & 63, g4 = lane >> 4, c16 = lane & 15;
    LAS unsigned char* Bs = lds + w * S5_WAVE; LAS unsigned char* Xs = Bs + 128 * S5_BUP; LAS float* xch = (LAS float*)(lds + S5_XCH);
    __syncthreads();
    float ar, ai, tcr, tci; s5_abar(P, g, lane, ar, ai, tcr, tci);
    bf16x8 Bb[8];
#pragma unroll
    for (int q = 0; q < 4; ++q) { const int pp = q * 16 + c16; float a0, a1, cr, ci; s5_abar(P, g, pp, a0, a1, cr, ci);
        unsigned wr_[4], wi_[4];
#pragma unroll
        for (int e = 0; e < 4; ++e) { float re[2], im[2];
#pragma unroll
            for (int h = 0; h < 2; ++h) { const int c = (g4 & 1) * 8 + 2 * e + h; const float br = P.b_re[((size_t)g * 64 + pp) * 16 + c], bi = P.b_im[((size_t)g * 64 + pp) * 16 + c];
                re[h] = cr * br - ci * bi; im[h] = cr * bi + ci * br; }
            wr_[e] = (g4 < 2) ? pk2(re[0], re[1]) : 0u; wi_[e] = (g4 < 2) ? pk2(im[0], im[1]) : 0u; }
        u32x4 a; a.x = wr_[0]; a.y = wr_[1]; a.z = wr_[2]; a.w = wr_[3]; Bb[q] = __builtin_bit_cast(bf16x8, a);
        u32x4 c; c.x = wi_[0]; c.y = wi_[1]; c.z = wi_[2]; c.w = wi_[3]; Bb[4 + q] = __builtin_bit_cast(bf16x8, c); }
    bf16x8 Cb[4];
#pragma unroll
    for (int kb = 0; kb < 4; ++kb) { unsigned wv[4];
#pragma unroll
        for (int e = 0; e < 4; ++e) { const int pidx = kb * 16 + g4 * 4 + e; const size_t ix = ((size_t)g * 16 + c16) * 64 + pidx; wv[e] = pk2(P.c_re[ix], -P.c_im[ix]); }
        u32x4 a; a.x = wv[0]; a.y = wv[1]; a.z = wv[2]; a.w = wv[3]; Cb[kb] = __builtin_bit_cast(bf16x8, a); }
    const float dsk = P.dsk[g * 16 + c16];
    const bf16* urow = PROJ + (size_t)(b * SEQ) * ODD_IN + g * 16;
    float xr = 0.f, xi = 0.f;
    for (int pass = 0; pass < 2; ++pass) {
        u32x4 uw = (u32x4){0u, 0u, 0u, 0u}; unsigned short us[4] = {0, 0, 0, 0};
        { const int tok0 = w * 512;
          if (g4 < 2) uw = *(const u32x4*)(urow + (size_t)(tok0 + c16) * ODD_IN + g4 * 8);
          if (pass == 1) {
#pragma unroll
              for (int j = 0; j < 4; ++j) us[j] = urow[(size_t)(tok0 + g4 * 4 + j) * ODD_IN + c16]; } }
        for (int blk = 0; blk < 32; ++blk) {
            const int tok0 = w * 512 + blk * 16;
            u32x4 uwn = (u32x4){0u, 0u, 0u, 0u}; unsigned short usn[4] = {0, 0, 0, 0};
            if (blk + 1 < 32) { const int tok1 = tok0 + 16;
                if (g4 < 2) uwn = *(const u32x4*)(urow + (size_t)(tok1 + c16) * ODD_IN + g4 * 8);
                if (pass == 1) {
#pragma unroll
                    for (int j = 0; j < 4; ++j) usn[j] = urow[(size_t)(tok1 + g4 * 4 + j) * ODD_IN + c16]; } }
            const bf16x8 ua = __builtin_bit_cast(bf16x8, uw);
#pragma unroll
            for (int nb = 0; nb < 8; ++nb) { f32x4 acc = (f32x4){0.f, 0.f, 0.f, 0.f};
                acc = __builtin_amdgcn_mfma_f32_16x16x32_bf16(ua, Bb[nb], acc, 0, 0, 0);
                *(LAS f32x4*)(Bs + (nb * 16 + c16) * S5_BUP + g4 * 16) = acc; }
            __syncthreads();
#pragma unroll
            for (int k = 0; k < 4; ++k) { const f32x4 br = *(const LAS f32x4*)(Bs + lane * S5_BUP + k * 16), bi = *(const LAS f32x4*)(Bs + (64 + lane) * S5_BUP + k * 16);
#pragma unroll
                for (int j = 0; j < 4; ++j) { const float nr = ar * xr - ai * xi + br[j], ni = ar * xi + ai * xr + bi[j]; xr = nr; xi = ni;
                    if (pass == 1) *(LAS unsigned*)(Xs + (k * 4 + j) * 272 + lane * 4) = pk2(xr, xi); } }
            if (pass == 1) {
                __syncthreads();
                f32x4 y = (f32x4){0.f, 0.f, 0.f, 0.f};
#pragma unroll
                for (int kb = 0; kb < 4; ++kb) { const bf16x8 xa = *(const LAS bf16x8*)(Xs + c16 * 272 + kb * 64 + g4 * 16); y = __builtin_amdgcn_mfma_f32_16x16x32_bf16(xa, Cb[kb], y, 0, 0, 0); }
#pragma unroll
                for (int j = 0; j < 4; ++j) { const int tok = tok0 + g4 * 4 + j; const float u = __uint_as_float((unsigned)us[j] << 16);
                    const float v = gelu_tanh(y[j] + dsk * u);
                    GB[(size_t)(b * SEQ + tok) * 1024 + g * 16 + c16] = (bf16)f2bf(v); }
            }
            __syncthreads();
            uw = uwn;
#pragma unroll
            for (int j = 0; j < 4; ++j) us[j] = usn[j];
        }
        if (pass == 0) {
            xch[(w * 64 + lane) * 2] = xr; xch[(w * 64 + lane) * 2 + 1] = xi;
            __syncthreads();
            float pr = ar, pi = ai;
#pragma unroll
            for (int s = 0; s < 9; ++s) { const float nr = pr * pr - pi * pi, ni = 2.f * pr * pi; pr = nr; pi = ni; }
            xr = 0.f; xi = 0.f;
            for (int j = 0; j < w; ++j) { const float er = xch[(j * 64 + lane) * 2], ei = xch[(j * 64 + lane) * 2 + 1];
                const float nr = pr * xr - pi * xi + er, ni = pr * xi + pi * xr + ei; xr = nr; xi = ni; }
        }
    }
}
#define x_in IN(0)
#define H ((float*)(ws + WS_H))
#define XN ((bf16*)(ws + WS_XN))
#define PROJ ((bf16*)(ws + WS_PROJ))
#define MIX ((bf16*)(ws + WS_MIX))
#define VT ((bf16*)(ws + WS_VT))
#define GB ((bf16*)(ws + WS_VT))
#define QX ((bf16*)(ws + WS_QX))
#define XO ((bf16*)(ws + WS_XO))
#define FLOG ((float*)(ws + WS_FLOG))
#define C2 ((float*)(ws + WS_C2))
#define MEMN ((bf16*)(ws + WS_MEMN))
#define KVX ((bf16*)(ws + WS_KVX))
#define VTX ((bf16*)(ws + WS_VTX))
#define ROPE ((float*)(ws + WS_ROPE))
#define WKVT ((bf16*)(ws + WS_WKVT))
#define WINT ((bf16*)(ws + WS_WINT))
#define WOUTT ((bf16*)(ws + WS_WOUTT))
#define WQT ((bf16*)(ws + WS_WQT))
#define WOT ((bf16*)(ws + WS_WOT))
#define W1T ((bf16*)(ws + WS_W1T))
#define W2T ((bf16*)(ws + WS_W2T))
#define WGLUT ((bf16*)(ws + WS_WGLUT))
#define SSQ ((float*)(ws + WS_SSQ))
#define IN(i) ((const float*)(const __attribute__((address_space(1))) float*)(unsigned long long)(args.in[(i) + zz]))
#define run_gemm(lds, ...) run_gemm_(lds, G, bid, __VA_ARGS__)
constexpr int PH_PER_LAYER = 10, N_PHASES = DEPTH * PH_PER_LAYER + 1;
using GOrder = pg8::StaticOrder;
template <class Epi> __device__ __forceinline__ void run_gemm_(LAS unsigned char* lds, int G, int bid, const bf16* A, const bf16* Bt, int M, int N, int K, const Epi& E) {
    pg8::Gemm g{A, Bt, M, N, K}; GOrder S; S.init(M, N, G, bid);
#ifndef NO_GEMM
    pg8::gemm_phase<Epi, GOrder, true, true>(lds, g, S, E);
#endif
}

#define RLX_AGENT __ATOMIC_RELAXED, __HIP_MEMORY_SCOPE_AGENT
#define XB_TMO      128
#define XB_XCNT(j)  (256  + 64 * (j))
#define XB_XSUB(j)  (1280 + 64 * (j))
#define XB_XGEN(j)  (2304 + 64 * (j))
#define XB_TOP      3328
#define XB_TOPGEN   3392
#define XCD_BAR_WORDS 3456
#define XB_SPIN_CAP (1u << 23)

__device__ __forceinline__ unsigned xb_ld(unsigned* p)              { return __hip_atomic_load(p, __ATOMIC_RELAXED, __HIP_MEMORY_SCOPE_AGENT); }
__device__ __forceinline__ unsigned xb_add(unsigned* p, unsigned v) { return __hip_atomic_fetch_add(p, v, __ATOMIC_RELAXED, __HIP_MEMORY_SCOPE_AGENT); }
__device__ __forceinline__ unsigned xb_xcc_id() { return (unsigned)__builtin_amdgcn_s_getreg((3 << 11) | 20) & 0xFu; }
#define XB_SPIN(cond, bar) do { unsigned _sp = 0; while (cond) { __builtin_amdgcn_s_sleep(1); \
    if ((++_sp & 255u) == 0u) { if (xb_ld(&(bar)[XB_TMO])) break; if (_sp > XB_SPIN_CAP) { atomicAdd(&(bar)[XB_TMO], 1u); break; } } } } while (0)

struct XcdBarrier {
    unsigned* bar; unsigned x;
    volatile LAS unsigned* st;
};

__device__ __forceinline__ XcdBarrier xcd_barrier_post(unsigned* bar, volatile LAS unsigned* st) {
    XcdBarrier b; b.bar = bar; b.x = xb_xcc_id(); b.st = st;
    if (threadIdx.x == 0) (void)xb_add(&bar[XB_XCNT(b.x)], 1u);
    return b;
}
__device__ __forceinline__ void xcd_barrier_complete(unsigned* bar, unsigned x, unsigned& nloc, unsigned& nx) {
    const unsigned G = gridDim.x * gridDim.y * gridDim.z;
    unsigned sum, cnt, mine, sp = 0u;
    for (;;) {
        sum = 0u; cnt = 0u; mine = 0u;
#pragma unroll
        for (unsigned j = 0; j < 16; ++j) { const unsigned c = xb_ld(&bar[XB_XCNT(j)]); sum += c; cnt += (c > 0u) ? 1u : 0u; mine = (j == x) ? c : mine; }
        if (sum == G) break;
        __builtin_amdgcn_s_sleep(1);
        if ((++sp & 255u) == 0u) { if (xb_ld(&bar[XB_TMO])) break; if (sp > XB_SPIN_CAP) { atomicAdd(&bar[XB_TMO], 1u); break; } }
    }
    nloc = mine > 0u ? mine : 1u; nx = cnt > 0u ? cnt : 1u;
}

__device__ __forceinline__ void xcd_barrier(const XcdBarrier& b) {
    asm volatile("s_waitcnt vmcnt(0)" ::: "memory");
    __syncthreads();
    if (threadIdx.x == 0) {
        unsigned* bar = b.bar;
        __builtin_amdgcn_s_waitcnt(0);
        unsigned nloc = b.st[0], nx = b.st[1];
        if (nloc == 0u) { xcd_barrier_complete(bar, b.x, nloc, nx); b.st[0] = nloc; b.st[1] = nx; }
        const unsigned old = xb_add(&bar[XB_XSUB(b.x)], 1u);
        const unsigned gen = old / nloc;
        if (old + 1u == (gen + 1u) * nloc) {
            __builtin_amdgcn_fence(__ATOMIC_RELEASE, "agent");
            asm volatile("s_waitcnt vmcnt(0)" ::: "memory");
            const unsigned og = xb_add(&bar[XB_TOP], 1u);
            const unsigned tg = og / nx;
            if (og + 1u == (tg + 1u) * nx) xb_add(&bar[XB_TOPGEN], 1u);
            else XB_SPIN(xb_ld(&bar[XB_TOPGEN]) == tg, bar);
            __builtin_amdgcn_fence(__ATOMIC_ACQUIRE, "agent");
            xb_add(&bar[XB_XGEN(b.x)], 1u);
            asm volatile("s_waitcnt vmcnt(0)" ::: "memory");
        } else {
            XB_SPIN(xb_ld(&bar[XB_XGEN(b.x)]) == gen, bar);
            __builtin_amdgcn_fence(__ATOMIC_ACQUIRE, "agent");
            asm volatile("s_waitcnt vmcnt(0)" ::: "memory");
        }
    }
    __syncthreads();
}

__device__ __forceinline__ void grid_bar(unsigned* cnt, unsigned target) {
#ifdef DBG_DELAY
    { const unsigned long long t0 = __builtin_amdgcn_s_memrealtime(); while (__builtin_amdgcn_s_memrealtime() - t0 < (unsigned long long)DBG_DELAY) __builtin_amdgcn_s_sleep(8); }
#endif
    asm volatile("s_waitcnt vmcnt(0) lgkmcnt(0)" ::: "memory");
    __syncthreads();
    if (threadIdx.x == 0) {
        __builtin_amdgcn_fence(__ATOMIC_RELEASE, "");
        asm volatile("s_waitcnt vmcnt(0)" ::: "memory");
        __hip_atomic_fetch_add(cnt, 1u, __ATOMIC_RELAXED, __HIP_MEMORY_SCOPE_AGENT);
        while (__hip_atomic_load(cnt, __ATOMIC_RELAXED, __HIP_MEMORY_SCOPE_AGENT) < target) __builtin_amdgcn_s_sleep(1);
        __builtin_amdgcn_fence(__ATOMIC_ACQUIRE, "");
        asm volatile("s_waitcnt vmcnt(0)" ::: "memory");
    }
    __syncthreads();
}
__global__ void __launch_bounds__(512, 2) trunk_fwd(Args args) {
    extern __shared__ __attribute__((aligned(16))) unsigned char lds_raw[];
    LAS unsigned char* lds = (LAS unsigned char*)lds_raw;
    cg::grid_group grid = cg::this_grid();
    const int lo = args.ph_lo, hi = args.ph_hi;
    int ph = 0; unsigned nbar = 0; (void)nbar;
    if (threadIdx.x < 2) ((volatile LAS unsigned*)(lds + LDS_BYTES - 64))[threadIdx.x] = 0u;
    __syncthreads();
    XcdBarrier xbar = xcd_barrier_post((unsigned*)args.ws, (volatile LAS unsigned*)(lds + LDS_BYTES - 64));
#ifdef DBG_LDSFILL
    for (int i = threadIdx.x; i < LDS_BYTES / 16; i += 512) ((LAS u32x4*)lds)[i] = (u32x4){0u, 0u, 0u, 0u};
    __syncthreads();
#endif
#ifdef DBG_FILL
    { u32x4* p = (u32x4*)(args.ws + MiB); const size_t n = (WS_END - MiB) / 16; for (size_t i = (size_t)blockIdx.x * 512 + threadIdx.x; i < n; i += (size_t)gridDim.x * 512) p[i] = (u32x4){0u, 0u, 0u, 0u}; }
#endif
    if (hi - lo > 1) grid.sync();
#ifndef DBG_NPH
#define DBG_NPH 1000
#endif
#define PH_BEGIN if (ph >= lo && ph < hi && (ph < DBG_NPH || ph == N_PHASES - 1)) { __attribute__((address_space(1))) unsigned char* ws = (__attribute__((address_space(1))) unsigned char*)(unsigned long long)args.ws; int zz = 0; int tid = threadIdx.x; int G = gridDim.x; int bid = blockIdx.x; asm volatile("" : "+s"(ws), "+s"(zz), "+v"(tid), "+s"(G), "+s"(bid)); const int lane = tid & 63, wave = __builtin_amdgcn_readfirstlane(tid >> 6), gw = bid * 8 + wave, NGW = G * 8; (void)lane; (void)gw; (void)NGW;
#ifdef DBG_DUP_BAR
#define PH_END } if (ph >= lo && ph + 1 < hi) { ++nbar; grid_bar((unsigned*)args.ws, nbar * gridDim.x); ++nbar; grid_bar((unsigned*)args.ws, nbar * gridDim.x); } ++ph;
#else
#define PH_END } if (ph >= lo && ph + 1 < hi) { xcd_barrier(xbar); } ++ph;
#endif

#ifdef DBG_COPYX
    { const float* xs = args.in[0]; for (size_t i = (size_t)blockIdx.x * 512 + threadIdx.x; i < (size_t)NT * DM; i += (size_t)gridDim.x * 512) args.out[i] = xs[i]; return; }
#endif
#ifdef DBG_BARTEST
    { float* flag = (float*)(args.ws + 512 * 1024);
      if (blockIdx.x == 5) { const unsigned long long t0 = __builtin_amdgcn_s_memrealtime(); while (__builtin_amdgcn_s_memrealtime() - t0 < 300000ull) __builtin_amdgcn_s_sleep(8);
          if (threadIdx.x == 0) flag[0] = 1234.5f; }
#if DBG_BARTEST == 1
      ++nbar; grid_bar((unsigned*)args.ws, nbar * gridDim.x);
#else
      grid.sync();
#endif
      const float f = __hip_atomic_load(flag, __ATOMIC_RELAXED, __HIP_MEMORY_SCOPE_AGENT);
      for (size_t i = (size_t)blockIdx.x * 512 + threadIdx.x; i < (size_t)NT * DM; i += (size_t)gridDim.x * 512) args.out[i] = f;
      return; }
#endif
#pragma unroll 1
    for (int layer = 0; layer < DEPTH; ++layer) {
        const bool even = (layer & 1) == 0;
#ifdef DBG_SUB0
        const int sub = 0;
#else
        const int sub = layer >> 1;
#endif
        PH_BEGIN
            LAS float* scr = (LAS float*)(lds + wave * 16384); int tbase = 0;
#ifdef DBG_DUP_A
            for (int rep = 0; rep < 2; ++rep) {
#endif
            if (layer == 0) {
                rms_rows(IN(1), IN(5), MEMN, nullptr, NB * MEML, gw, NGW, lane);
                for (int l = 0; l < DEPTH; ++l) tr_matrix(IN(23) + (size_t)l * DM * 1024, 1024, DM, 0, 1024, WKVT, l * 1024, scr, gw, NGW, lane, tbase);
                for (int idx = bid * 512 + tid; idx < SEQ * 64; idx += G * 512) { const int pos = idx >> 6, i = idx & 63;
                    const float inv = powf(10000.f, -(float)i * (1.f / 64.f)); const float ang = (float)pos * inv;
                    const double rev = (double)ang * 0.15915494309189535; const float fr = (float)(rev - floor(rev));
                    ROPE[idx] = __builtin_amdgcn_cosf(fr); ROPE[SEQ * 64 + idx] = __builtin_amdgcn_sinf(fr); }
            }
            if (even) {
                const float* Win = IN(7) + (size_t)sub * DM * EVEN_IN;
                tr_matrix(Win, EVEN_IN, DM, 0, 3072, WINT, 0, scr, gw, NGW, lane, tbase);
                tr_matrix(Win, EVEN_IN, DM, 3080, 4096, WINT, 3072, scr, gw, NGW, lane, tbase);
                tr_matrix(IN(9) + (size_t)sub * DM * DM, DM, DM, 0, DM, WOUTT, 0, scr, gw, NGW, lane, tbase);
            } else {
                tr_matrix(IN(10) + (size_t)sub * DM * ODD_IN, ODD_IN, DM, 0, ODD_IN, WINT, 0, scr, gw, NGW, lane, tbase, IN(2) + layer * DM);
                tr_matrix(IN(19) + (size_t)sub * 1024 * 1024, 1024, 1024, 0, 1024, WGLUT, 0, scr, gw, NGW, lane, tbase);
                tr_matrix(IN(21) + (size_t)sub * DM * DM, DM, DM, 0, DM, WOUTT, 0, scr, gw, NGW, lane, tbase);
            }
            tr_matrix(IN(22) + (size_t)layer * DM * XAW, XAW, DM, 0, XAW, WQT, 0, scr, gw, NGW, lane, tbase, IN(3) + layer * DM);
            tr_matrix(IN(24) + (size_t)layer * XAW * DM, DM, XAW, 0, DM, WOT, 0, scr, gw, NGW, lane, tbase);
            tr_matrix(IN(25) + (size_t)layer * DM * DFF, DFF, DM, 0, DFF, W1T, 0, scr, gw, NGW, lane, tbase, IN(4) + layer * DM);
            tr_matrix(IN(26) + (size_t)layer * DFF * DM, DM, DFF, 0, DM, W2T, 0, scr, gw, NGW, lane, tbase);
            if (even) {
                __syncthreads();
                const float* wf = IN(7) + (size_t)sub * DM * EVEN_IN + 3072; LAS f32x4* wfl = (LAS f32x4*)lds;
                for (int i = tid; i < 4096; i += 512) { const int k = i >> 1, half = i & 1; wfl[((((k >> 8) * 4 + (k & 3)) * 2 + half) * 64) + ((k >> 2) & 63)] = *(const f32x4*)(wf + (size_t)k * EVEN_IN + half * 4); }
                __syncthreads();
                rms_rows((layer == 0) ? x_in : H, IN(2) + layer * DM, XN, nullptr, NT, gw, NGW, lane, wfl, FLOG);
            }
#ifdef DBG_DUP_A
            }
#endif
        PH_END
        PH_BEGIN
            if (even) { pg8::EpiBf E{PROJ, EVEN_LD, 0, nullptr, -1, nullptr}; run_gemm(lds, XN, WINT, NT, EVEN_N, DM, E); }
#ifdef DBG_TWICE
            if (layer == 2) { pg8::EpiBf E2{MIX, DM, 0, nullptr, -1, nullptr}; run_gemm(lds, XN, WINT, NT, DM, DM, E2); }
#endif
            else { pg8::EpiBf E{PROJ, ODD_IN, 0, nullptr, -1, SSQ}; run_gemm(lds, XN, WINT, NT, ODD_IN, DM, E); }
            if (layer == 0) { pg8::EpiBf E{KVX, 4096, 0, nullptr, -1, nullptr}; run_gemm(lds, MEMN, WKVT, NB * MEML, 4096, DM, E); }
        PH_END
        if (even) {
            PH_BEGIN
                if (bid < 32) {
                    const int b = bid >> 3, h = bid & 7; const float bias = IN(8)[sub * 8 + h];
                    float v[8]; float run = 0.f;
#pragma unroll
                    for (int e = 0; e < 8; ++e) { const float xx = FLOG[(size_t)(b * SEQ + tid * 8 + e) * 8 + h] + bias;
                        const float ls = fminf(xx, 0.f) - log1pf(__expf(-fabsf(xx))); run += ls; v[e] = run; }
                    float inc = run;
#pragma unroll
                    for (int o = 1; o < 64; o <<= 1) { const float t = __shfl_up(inc, o); if (lane >= o) inc += t; }
                    LAS float* wsum = (LAS float*)(lds + 131072);
                    __syncthreads();
                    if (lane == 63) wsum[wave] = inc;
                    __syncthreads();
                    float off = inc - run;
                    for (int j = 0; j < wave; ++j) off += wsum[j];
#pragma unroll
                    for (int e = 0; e < 8; ++e) C2[(size_t)(b * 8 + h) * SEQ + tid * 8 + e] = (v[e] + off) * LOG2E;
                }
                for (int t = gw; t < NT; t += NGW) { const int pos = t & (SEQ - 1), slot = lane >> 2, i0 = (lane & 3) * 16;
                    bf16* p1 = PROJ + (size_t)t * EVEN_LD + 3072 + slot * 128 + i0; bf16* p2 = p1 + 64;
                    const float sc = (slot >= 8) ? QK_SCALE : 1.f;
#pragma unroll
                    for (int hlf = 0; hlf < 2; ++hlf) { const u32x4 a = *(const u32x4*)(p1 + hlf * 8), c = *(const u32x4*)(p2 + hlf * 8); u32x4 o1, o2;
#pragma unroll
                        for (int e = 0; e < 4; ++e) { const int ii = i0 + hlf * 8 + 2 * e;
                            const float c0 = ROPE[pos * 64 + ii], c1 = ROPE[pos * 64 + ii + 1], s0 = ROPE[SEQ * 64 + pos * 64 + ii], s1 = ROPE[SEQ * 64 + pos * 64 + ii + 1];
                            const float a0 = bflo(a[e]), a1 = bfhi(a[e]), b0 = bflo(c[e]), b1 = bfhi(c[e]);
                            o1[e] = pk2((a0 * c0 - b0 * s0) * sc, (a1 * c1 - b1 * s1) * sc); o2[e] = pk2((a0 * s0 + b0 * c0) * sc, (a1 * s1 + b1 * c1) * sc); }
                        *(u32x4*)(p1 + hlf * 8) = o1; *(u32x4*)(p2 + hlf * 8) = o2; } }
                { LAS unsigned char* scr = lds + wave * 9216;
                  for (int it = gw; it < NB * 16 * 64 * 2; it += NGW) { const int dh = it & 1, tb = (it >> 1) & 63, h16 = (it >> 7) & 15, b = it >> 11;
                      const bf16* src = PROJ + (size_t)(b * SEQ + tb * 64) * EVEN_LD + (h16 < 8 ? 2048 + h16 * 128 : 5120 + (h16 - 8) * 128) + dh * 64;
                      bf16* dst = VT + ((size_t)(b * 16 + h16) * 128 + dh * 64) * SEQ + tb * 64;
                      tr_bf16_64x64(src, EVEN_LD, dst, SEQ, scr, lane); }
                  if (layer == 0) for (int it = gw; it < DEPTH * NB * 4 * 4 * 2; it += NGW) { const int dh = it & 1, kb = (it >> 1) & 3, h = (it >> 3) & 3, b = (it >> 5) & 3, l = it >> 7;
                      const bf16* src = KVX + (size_t)(b * MEML + kb * 64) * 4096 + l * 1024 + 512 + h * 128 + dh * 64;
                      bf16* dst = VTX + ((size_t)((l * NB + b) * 4 + h) * 128 + dh * 64) * MEML + kb * 64;
                      tr_bf16_64x64(src, 4096, dst, MEML, scr, lane); } }
            PH_END
            PH_BEGIN
                const int NU = NB * 16 * 16;
#ifdef DBG_DUP_ATTN
                for (int rep = 0; rep < 2; ++rep)
#endif
                for (int r = 0; r * G < NU; ++r) { const int sidx = r * G + ((r & 1) ? (G - 1 - bid) : bid); if (sidx >= NU) continue;
                    const int qb = 15 - (sidx >> 6), bh = sidx & 63, b = bh >> 4, h16 = bh & 15, h = h16 & 7;
                    const bf16* rowb = PROJ + (size_t)(b * SEQ) * EVEN_LD; const bf16* vt = VT + (size_t)(b * 16 + h16) * 128 * SEQ; bf16* ob = MIX + (size_t)(b * SEQ) * DM;
#ifndef NO_ATTN
                    if (h16 < 8) attn_unit<0>(lds, rowb + h * 128, EVEN_LD, rowb + 1024 + h * 128, EVEN_LD, vt, SEQ, ob + h * 128, DM, qb * 256, 0, C2 + (size_t)(b * 8 + h) * SEQ, 0.f, nullptr);
                    else { const float l2g = log2f(1.f - exp2f(-5.f - (float)h));
                        attn_unit<1>(lds, rowb + 3072 + h * 128, EVEN_LD, rowb + 4096 + h * 128, EVEN_LD, vt, SEQ, ob + 1024 + h * 128, DM, qb * 256, 0, nullptr, l2g, rowb + 6144 + h * 128); }
#endif
                }
            PH_END
        } else {
            PH_BEGIN
#ifdef DBG_DUP_S5
                for (int rep = 0; rep < 2; ++rep) {
#endif
                S5P P{IN(11) + sub * 4096, IN(12) + sub * 4096, IN(13) + (size_t)sub * 65536, IN(14) + (size_t)sub * 65536,
                      IN(15) + (size_t)sub * 65536, IN(16) + (size_t)sub * 65536, IN(17) + sub * 1024, IN(18) + sub * 4096};
#ifndef NO_S5
                for (int u = bid; u < NB * 64; u += G) s5_unit(lds, u >> 6, u & 63, PROJ, GB, P);
#endif
                const float* cw = IN(20) + sub * 3 * 1024;
                for (int idx = bid * 512 + tid; idx < NT * 128; idx += G * 512) { const int tok = idx >> 7, ch = (idx & 127) * 8, l = tok & (SEQ - 1);
                    const bf16* row = PROJ + (size_t)tok * ODD_IN;
                    float acc[8];
#pragma unroll
                    for (int e = 0; e < 8; ++e) acc[e] = 0.f;
#pragma unroll
                    for (int k = 0; k < 3; ++k) { const int back = 2 - k; if (l - back < 0) continue;
                        const u32x4 hv = *(const u32x4*)(row - (size_t)back * ODD_IN + 1024 + ch), gc = *(const u32x4*)(row - (size_t)back * ODD_IN + 3072 + ch);
                        const f32x4 w0 = *(const f32x4*)(cw + k * 1024 + ch), w1 = *(const f32x4*)(cw + k * 1024 + ch + 4);
#pragma unroll
                        for (int e = 0; e < 4; ++e) { const float wa = (e < 2) ? w0[2 * e] : w1[2 * e - 4], wb = (e < 2) ? w0[2 * e + 1] : w1[2 * e - 3];
                            acc[2 * e] += wa * (bflo(hv[e]) * bflo(gc[e])); acc[2 * e + 1] += wb * (bfhi(hv[e]) * bfhi(gc[e])); } }
                    const u32x4 gb = *(const u32x4*)(row + 2048 + ch); u32x4 o;
#pragma unroll
                    for (int e = 0; e < 4; ++e) o[e] = pk2(bflo(gb[e]) * acc[2 * e], bfhi(gb[e]) * acc[2 * e + 1]);
                    *(u32x4*)(MIX + (size_t)tok * DM + 1024 + ch) = o; }
#ifdef DBG_DUP_S5
                }
#endif
            PH_END
            PH_BEGIN
                pg8::EpiGlu E{GB, 1024, MIX, DM}; run_gemm(lds, GB, WGLUT, NT, 1024, 1024, E);
            PH_END
        }
        PH_BEGIN
            pg8::EpiResid E{(layer == 0) ? x_in : H, H, DM, XN, SSQ}; run_gemm(lds, MIX, WOUTT, NT, DM, DM, E);
        PH_END
        PH_BEGIN
            pg8::EpiBf E{QX, XAW, 0, nullptr, -1, SSQ}; run_gemm(lds, XN, WQT, NT, XAW, DM, E);
        PH_END
        PH_BEGIN
            for (int u = bid; u < NB * 4 * 16; u += G) { const int qb = u & 15, h = (u >> 4) & 3, b = u >> 6;
#ifndef NO_XATTN
                attn_unit<2>(lds, QX + (size_t)(b * SEQ) * XAW + h * 128, XAW, KVX + (size_t)(b * MEML) * 4096 + layer * 1024 + h * 128, 4096,
                             VTX + (size_t)((layer * NB + b) * 4 + h) * 128 * MEML, MEML, XO + (size_t)(b * SEQ) * XAW + h * 128, XAW, qb * 256, MEML, nullptr, 0.f, nullptr);
#endif
            }
        PH_END
        PH_BEGIN
            pg8::EpiResid E{H, H, DM, XN, SSQ}; run_gemm(lds, XO, WOT, NT, DM, XAW, E);
        PH_END
        PH_BEGIN
#ifndef DBG_SKIPMLP
            pg8::EpiBf E{PROJ, DFF, 1, nullptr, -1, SSQ}; run_gemm(lds, XN, W1T, NT, DFF, DM, E);
#endif
        PH_END
        PH_BEGIN
#ifndef DBG_SKIPMLP
            pg8::EpiResid E{H, H, DM, even ? XN : nullptr, even ? SSQ : nullptr}; run_gemm(lds, PROJ, W2T, NT, DM, DFF, E);
#endif
        PH_END
    }
    PH_BEGIN
#ifdef DBG_OUTBUF
        { const bf16* src = (const bf16*)(ws + DBG_OUTBUF); for (size_t i = (size_t)bid * 512 + tid; i < (size_t)NT * DM; i += (size_t)G * 512) { const size_t t = i >> 11, c = i & 2047; float v = __uint_as_float((unsigned)src[t * DBG_OUTLD + DBG_OUTCOL + c] << 16);
#ifdef DBG_TWICE
            v -= __uint_as_float((unsigned)MIX[t * DM + c] << 16);
#endif
            args.out[i] = v; } }
#else
        rms_rows(H, IN(6), nullptr, args.out, NT, gw, NGW, lane);
#endif
    PH_END
#undef PH_BEGIN
#undef PH_END
}
#undef H
#undef XN
#undef PROJ
#undef MIX
#undef VT
#undef GB
#undef QX
#undef XO
#undef IN
#undef x_in

extern "C" void kernel_launch(void* const* d_in, const int* in_sizes, int n_in, void* d_out, int out_size, void* d_ws, size_t ws_size, hipStream_t stream) {
    static int grid = 0;
    if (grid == 0) {
        if (n_in != 27 || out_size != NT * DM || ws_size < WS_END) { fprintf(stderr, "kernel_launch: unexpected problem (n_in %d out %d ws %zu, need %zu)\n", n_in, out_size, ws_size, (size_t)WS_END); grid = -1; return; }
        int dev = 0, cus = 0, per_cu = 0;
        hipGetDevice(&dev); hipDeviceGetAttribute(&cus, hipDeviceAttributeMultiprocessorCount, dev);
        if (hipFuncSetAttribute((const void*)trunk_fwd, hipFuncAttributeMaxDynamicSharedMemorySize, LDS_BYTES) != hipSuccess) { fprintf(stderr, "kernel_launch: hipFuncSetAttribute failed\n"); grid = -1; return; }
        hipOccupancyMaxActiveBlocksPerMultiprocessor(&per_cu, (const void*)trunk_fwd, 512, LDS_BYTES);
        if (per_cu < 1) { fprintf(stderr, "kernel_launch: occupancy query says %d blocks/CU\n", per_cu); per_cu = 1; }
        (void)hipGetLastError();
        grid = cus * 1;
    }
    if (grid < 0) return;
    (void)hipMemsetAsync(d_ws, 0, 16384, stream);
    Args a{};
    for (int i = 0; i < 27; ++i) a.in[i] = (const float*)d_in[i];
    a.out = (float*)d_out; a.ws = (unsigned char*)d_ws;
#if MK_ONE_LAUNCH
    a.ph_lo = 0; a.ph_hi = N_PHASES;
    { void* kargs[] = {&a}; hipError_t e = hipLaunchCooperativeKernel((const void*)trunk_fwd, dim3(grid), dim3(512), kargs, LDS_BYTES, stream);
      if (e != hipSuccess) fprintf(stderr, "cooperative launch failed: %s (grid %d)\n", hipGetErrorString(e), grid); }
#else
    for (int p = 0; p < N_PHASES; ++p) { a.ph_lo = p; a.ph_hi = p + 1;
        void* kargs[] = {&a}; hipError_t e = hipLaunchCooperativeKernel((const void*)trunk_fwd, dim3(grid), dim3(512), kargs, LDS_BYTES, stream);
        if (e != hipSuccess) { fprintf(stderr, "launch %d failed: %s (grid %d)\n", p, hipGetErrorString(e), grid); break; } }
#endif
}
```

```cpp
#include <hip/hip_runtime.h>
#include <hip/hip_cooperative_groups.h>
#include <cstdio>
#include <cstdint>
namespace cg = cooperative_groups;
#ifndef PG8_AUX
#define PG8_AUX 0
#endif
namespace pg8 {
#define PG8_LAS __attribute__((address_space(3)))
typedef unsigned short bf16_t;
typedef short bf16x8 __attribute__((ext_vector_type(8)));
typedef float f32x4 __attribute__((ext_vector_type(4)));
typedef unsigned u32x4 __attribute__((ext_vector_type(4)));
constexpr int BM = 256, BK = 64, HALF = 128, HTB = HALF * BK * 2  , STAGE_BYTES = 8 * HTB, NXCD = 8, WGM = 8;

__host__ __device__ __forceinline__ int lds_byte(int r, int c) { const int st = (r >> 4) * 2 + (c >> 5), rr = r & 15, cc = c & 31, ob = rr * 64 + cc * 2; return st * 1024 + (ob ^ (((ob >> 9) & 1) << 5)); }
__host__ __device__ __forceinline__ void stage_rc(int b, int& R, int& C) { const int st = b / 1024, sb = b % 1024, swz = sb ^ (((sb >> 9) & 1) << 5); R = (st >> 1) * 16 + swz / 64; C = (st & 1) * 32 + (swz % 64) / 2; }
__host__ __device__ __forceinline__ int perm32(int rho) { const int n = rho >> 4, i = rho & 15; return 8 * (i >> 2) + 4 * n + (i & 3); }

struct Unit { int pm, pn; };
struct Gemm { const bf16_t* A; const bf16_t* Bt; int M, N, K; };

struct StaticOrder {
    int nM, nN, nwg, G, c;
    __host__ __device__ void init(int M, int N, int G_, int c_) { nM = M / BM; nN = N / BM; nwg = nM * nN; G = G_; c = c_; }
    __host__ __device__ bool next(int i, Unit& u) const {
        const long L = (long)i * G + c; if (L >= nwg) return false;
        int wgid = (int)L; { const int q = nwg / NXCD, r = nwg % NXCD, xcd = wgid % NXCD, off = wgid / NXCD; wgid = (xcd < r ? xcd * (q + 1) : r * (q + 1) + (xcd - r) * q) + off; }
        const int nig = WGM * nN, gid = wgid / nig, fm = gid * WGM, gsz = (nM - fm) < WGM ? (nM - fm) : WGM;
        u.pm = fm + ((wgid % nig) % gsz); u.pn = (wgid % nig) / gsz; return true;
    }
    __device__ __forceinline__ void a_ready(const Unit&) const {}
    __device__ __forceinline__ void done(const Unit&) const {}
};

__device__ __forceinline__ unsigned cvt_pk_bf16(float lo, float hi) { unsigned r; asm volatile("v_cvt_pk_bf16_f32 %0, %1, %2" : "=v"(r) : "v"(lo), "v"(hi)); return r; }
struct EpiBf {
    static constexpr bool PERM = true, AFTER_DRAIN = false;
    bf16_t* O; int ldc; int act; float* flog; int flog_tile; const float* ssq;
    __device__ __forceinline__ void operator()(const f32x4 (&acc)[2][2][4][2], const Unit& u, int wr, int wc, int fr, int fq) const {
        const int row0 = u.pm * BM + wr * 64 + fr;
        if (u.pn == flog_tile) {
            if (wc == 0 && fq == 0) {
#pragma unroll
                for (int ai = 0; ai < 2; ++ai)
#pragma unroll
                    for (int m = 0; m < 4; ++m) { float* p = flog + (size_t)(row0 + ai * HALF + m * 16) * 8; *(f32x4*)p = acc[ai][0][m][0]; *(f32x4*)(p + 4) = acc[ai][0][m][1]; }
            }
            return;
        }
        const int col0 = u.pn * BM + wc * 32 + 8 * fq;
#pragma unroll
        for (int ai = 0; ai < 2; ++ai)
#pragma unroll
            for (int m = 0; m < 4; ++m) { bf16_t* rowp = O + (size_t)(row0 + ai * HALF + m * 16) * ldc + col0;
                float rs = 1.f;
                if (ssq) { const f32x4* sp = (const f32x4*)(ssq + (size_t)(row0 + ai * HALF + m * 16) * 32) + fq * 2; const f32x4 a = sp[0], b = sp[1];
                    float s = ((a.x + a.y) + (a.z + a.w)) + ((b.x + b.y) + (b.z + b.w)); s += __shfl_xor(s, 16); s += __shfl_xor(s, 32); rs = rsqrtf(s * (1.f / 2048.f) + 1e-6f); }
#pragma unroll
                for (int bj = 0; bj < 2; ++bj) { f32x4 v0 = acc[ai][bj][m][0] * rs, v1 = acc[ai][bj][m][1] * rs;
                    if (act) {
#pragma unroll
                        for (int e = 0; e < 4; ++e) { float a = fmaxf(v0[e], 0.f), b = fmaxf(v1[e], 0.f); v0[e] = a * a; v1[e] = b * b; } }
                    u32x4 w; w.x = cvt_pk_bf16(v0[0], v0[1]); w.y = cvt_pk_bf16(v0[2], v0[3]); w.z = cvt_pk_bf16(v1[0], v1[1]); w.w = cvt_pk_bf16(v1[2], v1[3]);
                    *(u32x4*)(rowp + bj * HALF) = w; } }
    }
};
struct EpiResid {
    static constexpr bool PERM = true, AFTER_DRAIN = false;
    const float* base; float* out; int ldc; bf16_t* xb; float* ssq;
    __device__ __forceinline__ void operator()(const f32x4 (&acc)[2][2][4][2], const Unit& u, int wr, int wc, int fr, int fq) const {
        const int col0 = u.pn * BM + wc * 32 + 8 * fq;
#pragma unroll
        for (int ai = 0; ai < 2; ++ai) {
            f32x4 bs[4][2][2];
#pragma unroll
            for (int m = 0; m < 4; ++m) { const size_t off = (size_t)(u.pm * BM + ai * HALF + wr * 64 + m * 16 + fr) * ldc + col0;
#pragma unroll
                for (int bj = 0; bj < 2; ++bj) { bs[m][bj][0] = *(const f32x4*)(base + off + bj * HALF); bs[m][bj][1] = *(const f32x4*)(base + off + bj * HALF + 4); } }
#pragma unroll
            for (int m = 0; m < 4; ++m) { const int row = u.pm * BM + ai * HALF + wr * 64 + m * 16 + fr; const size_t off = (size_t)row * ldc + col0; float s = 0.f;
#pragma unroll
                for (int bj = 0; bj < 2; ++bj) { const f32x4 o0 = bs[m][bj][0] + acc[ai][bj][m][0], o1 = bs[m][bj][1] + acc[ai][bj][m][1];
                    *(f32x4*)(out + off + bj * HALF) = o0; *(f32x4*)(out + off + bj * HALF + 4) = o1;
                    if (xb) { s += ((o0.x * o0.x + o0.y * o0.y) + (o0.z * o0.z + o0.w * o0.w)) + ((o1.x * o1.x + o1.y * o1.y) + (o1.z * o1.z + o1.w * o1.w));
                        u32x4 w; w.x = cvt_pk_bf16(o0.x, o0.y); w.y = cvt_pk_bf16(o0.z, o0.w); w.z = cvt_pk_bf16(o1.x, o1.y); w.w = cvt_pk_bf16(o1.z, o1.w);
                        *(u32x4*)(xb + off + bj * HALF) = w; } }
                if (xb) { s += __shfl_xor(s, 16); s += __shfl_xor(s, 32); if (fq == 0) ssq[(size_t)row * 32 + u.pn * 4 + wc] = s; } }
            asm volatile("" ::: "memory"); }
    }
};
struct EpiGlu {
    static constexpr bool PERM = true, AFTER_DRAIN = false;
    const bf16_t* Gm; int ldg; bf16_t* O; int ldc;
    __device__ __forceinline__ void operator()(const f32x4 (&acc)[2][2][4][2], const Unit& u, int wr, int wc, int fr, int fq) const {
        const int row0 = u.pm * BM + wr * 64 + fr, col0 = u.pn * BM + wc * 32 + 8 * fq;
#pragma unroll
        for (int ai = 0; ai < 2; ++ai)
#pragma unroll
            for (int m = 0; m < 4; ++m) { const size_t r = (size_t)(row0 + ai * HALF + m * 16);
#pragma unroll
                for (int bj = 0; bj < 2; ++bj) { const u32x4 gv = *(const u32x4*)(Gm + r * ldg + col0 + bj * HALF);
                    const f32x4 v0 = acc[ai][bj][m][0], v1 = acc[ai][bj][m][1]; float o[8];
#pragma unroll
                    for (int e = 0; e < 4; ++e) { const unsigned w = gv[e]; const float g0 = __uint_as_float(w << 16), g1 = __uint_as_float(w & 0xffff0000u);
                        const float a0 = (e < 2) ? v0[2 * e] : v1[2 * e - 4], a1 = (e < 2) ? v0[2 * e + 1] : v1[2 * e - 3];
                        o[2 * e] = g0 / (1.f + __expf(-a0)); o[2 * e + 1] = g1 / (1.f + __expf(-a1)); }
                    u32x4 w; w.x = cvt_pk_bf16(o[0], o[1]); w.y = cvt_pk_bf16(o[2], o[3]); w.z = cvt_pk_bf16(o[4], o[5]); w.w = cvt_pk_bf16(o[6], o[7]);
                    *(u32x4*)(O + r * ldc + col0 + bj * HALF) = w; }
                asm volatile("" ::: "memory"); }
    }
};
template <class Epi, class Sched, bool ALIGN_EPI = false, bool SP2 = false>
__device__ __forceinline__ void gemm_phase(PG8_LAS unsigned char* lds, const Gemm g, const Sched& S, const Epi& E) {
    int tid_ = threadIdx.x; asm volatile("" : "+v"(tid_));
    const int tid = tid_, wid = __builtin_amdgcn_readfirstlane(tid >> 6), lane = tid & 63, wr = wid >> 2, wc = wid & 3, fr = lane & 15, fq = lane >> 4;
    const int K = g.K, nt = K / BK;
    unsigned voffA[2], voffB[2];
#pragma unroll
    for (int i = 0; i < 2; ++i) { int R, C; stage_rc(tid * 16 + i * 8192, R, C); const int Rb = Epi::PERM ? ((R & ~31) + perm32(R & 31)) : R;
        voffA[i] = (unsigned)(R * K + C) * 2u; voffB[i] = (unsigned)(Rb * K + C) * 2u; }
    const size_t kstep = (size_t)(BK * 2);
    const size_t hstep = (size_t)HALF * K * 2;
    const size_t tstep = 2 * hstep;
    const unsigned ldsw = (unsigned)wid * 1024u;
    const int aoff = lds_byte(wr * 64 + fr, fq * 8), boff = lds_byte(wc * 32 + fr, fq * 8);
#define PG8_SA(b, h) (((b) * 2 + (h)) * HTB)
#define PG8_SB(b, h) ((4 + (b) * 2 + (h)) * HTB)
#define PG8_STAGE(bufoff, gbase, voff) do { _Pragma("unroll") for (int _i = 0; _i < 2; ++_i) \
        __builtin_amdgcn_global_load_lds((const unsigned*)((const char*)(gbase) + (voff)[_i]), (PG8_LAS unsigned*)(lds + (bufoff) + ldsw + _i * 8192), 16, 0, PG8_AUX); } while (0)
#define PG8_LDA(dst, b, h) do { _Pragma("unroll") for (int m = 0; m < 4; ++m) _Pragma("unroll") for (int k = 0; k < 2; ++k) dst[m][k] = *(const PG8_LAS bf16x8*)(lds + PG8_SA(b, h) + aoff + m * 2048 + k * 1024); } while (0)
#define PG8_LDB(dst, b, h) do { _Pragma("unroll") for (int n = 0; n < 2; ++n) _Pragma("unroll") for (int k = 0; k < 2; ++k) dst[n][k] = *(const PG8_LAS bf16x8*)(lds + PG8_SB(b, h) + boff + n * 2048 + k * 1024); } while (0)
#define PG8_MMA(ai, bj, At, Bt) do { __builtin_amdgcn_s_setprio(1); _Pragma("unroll") for (int m = 0; m < 4; ++m) _Pragma("unroll") for (int n = 0; n < 2; ++n) _Pragma("unroll") for (int k = 0; k < 2; ++k) \
        acc[ai][bj][m][n] = __builtin_amdgcn_mfma_f32_16x16x32_bf16(Bt[n][k], At[m][k], acc[ai][bj][m][n], 0, 0, 0); __builtin_amdgcn_s_setprio(0); } while (0)
#ifdef DBG_DRAIN
#define PG8_WAIT_V(n) asm volatile("s_waitcnt vmcnt(0)" ::: "memory")
#else
#define PG8_WAIT_V(n) asm volatile("s_waitcnt vmcnt(" #n ")" ::: "memory")
#endif
#define PG8_WAIT_L(n) asm volatile("s_waitcnt lgkmcnt(" #n ")" ::: "memory")
#define PG8_BAR __builtin_amdgcn_s_barrier()
#define PG8_SCHED __builtin_amdgcn_sched_barrier(0)
    Unit cur, nxt; int ui = 0;
    if (!S.next(0, cur)) return;
    f32x4 acc[2][2][4][2];
#pragma unroll
    for (int a = 0; a < 2; ++a)
#pragma unroll
        for (int b = 0; b < 2; ++b)
#pragma unroll
            for (int m = 0; m < 4; ++m)
#pragma unroll
                for (int n = 0; n < 2; ++n) acc[a][b][m][n] = (f32x4){0.f, 0.f, 0.f, 0.f};
    bf16x8 At[4][2], B0[2][2], B1[2][2];
    const char* cA = (const char*)g.A + (size_t)cur.pm * tstep; const char* cB = (const char*)g.Bt + (size_t)cur.pn * tstep;
    S.a_ready(cur);
    if constexpr (SP2) {
        PG8_STAGE(PG8_SB(0, 0), cB, voffB); PG8_STAGE(PG8_SB(0, 1), cB + hstep, voffB); PG8_STAGE(PG8_SA(0, 0), cA, voffA); PG8_STAGE(PG8_SA(0, 1), cA + hstep, voffA);
        if (wr == 1) PG8_BAR;
        PG8_WAIT_V(2); PG8_BAR;
        PG8_STAGE(PG8_SB(1, 0), cB + kstep, voffB); PG8_STAGE(PG8_SA(1, 0), cA + kstep, voffA); PG8_STAGE(PG8_SB(1, 1), cB + hstep + kstep, voffB);
        PG8_WAIT_V(6); PG8_BAR;
    } else {
        PG8_STAGE(PG8_SB(0, 0), cB, voffB); PG8_STAGE(PG8_SA(0, 0), cA, voffA); PG8_STAGE(PG8_SB(0, 1), cB + hstep, voffB); PG8_STAGE(PG8_SA(0, 1), cA + hstep, voffA);
        if (wr == 1) PG8_BAR;
        PG8_WAIT_V(4); PG8_BAR;
        PG8_STAGE(PG8_SB(1, 0), cB + kstep, voffB); PG8_STAGE(PG8_SA(1, 0), cA + kstep, voffA); PG8_STAGE(PG8_SB(1, 1), cB + hstep + kstep, voffB);
        PG8_WAIT_V(6); PG8_BAR;
    }
    for (;;) {
        const bool has_next = S.next(ui + 1, nxt);
        const char* nA = has_next ? (const char*)g.A + (size_t)nxt.pm * tstep : cA; const char* nB = has_next ? (const char*)g.Bt + (size_t)nxt.pn * tstep : cB;
        for (int t = 0; t < nt; t += 2) {
            const bool last = (t == nt - 2);
            const char* a1 = cA + (size_t)(t + 1) * kstep;
            const char* a2 = last ? nA : cA + (size_t)(t + 2) * kstep; const char* b2 = last ? nB : cB + (size_t)(t + 2) * kstep;
            const char* a3 = a2 + kstep; const char* b3 = b2 + kstep;
            if (last && has_next) S.a_ready(nxt);
            if constexpr (SP2) {
            PG8_LDB(B0, 0, 0); PG8_LDB(B1, 0, 1); PG8_SCHED; PG8_LDA(At, 0, 0); PG8_STAGE(PG8_SA(1, 1), a1 + hstep, voffA);
            PG8_WAIT_V(8); PG8_WAIT_L(0); PG8_BAR; PG8_MMA(0, 0, At, B0); PG8_MMA(0, 1, At, B1); PG8_BAR; PG8_SCHED;
            PG8_LDA(At, 0, 1); PG8_STAGE(PG8_SB(0, 0), b2, voffB); PG8_STAGE(PG8_SB(0, 1), b2 + hstep, voffB); PG8_STAGE(PG8_SA(0, 0), a2, voffA);
            PG8_WAIT_V(8); PG8_WAIT_L(0); PG8_BAR; PG8_MMA(1, 0, At, B0); PG8_MMA(1, 1, At, B1); PG8_BAR; PG8_SCHED;
            PG8_LDB(B0, 1, 0); PG8_LDB(B1, 1, 1); PG8_SCHED; PG8_LDA(At, 1, 0); PG8_STAGE(PG8_SA(0, 1), a2 + hstep, voffA);
            PG8_WAIT_V(8); PG8_WAIT_L(0); PG8_BAR; PG8_MMA(0, 0, At, B0); PG8_MMA(0, 1, At, B1); PG8_BAR; PG8_SCHED;
            PG8_LDA(At, 1, 1); PG8_STAGE(PG8_SB(1, 0), b3, voffB); PG8_STAGE(PG8_SB(1, 1), b3 + hstep, voffB); PG8_STAGE(PG8_SA(1, 0), a3, voffA);
            PG8_WAIT_V(8); PG8_WAIT_L(0); PG8_BAR; PG8_MMA(1, 0, At, B0); PG8_MMA(1, 1, At, B1); PG8_BAR; PG8_SCHED;
            } else {
            PG8_LDB(B0, 0, 0); PG8_SCHED; PG8_LDA(At, 0, 0); PG8_STAGE(PG8_SA(1, 1), a1 + hstep, voffA);
            PG8_WAIT_L(8); PG8_BAR; PG8_WAIT_L(0); PG8_MMA(0, 0, At, B0); PG8_BAR; PG8_SCHED;
            PG8_LDB(B1, 0, 1); PG8_STAGE(PG8_SB(0, 0), b2, voffB);
            PG8_BAR; PG8_WAIT_L(0); PG8_MMA(0, 1, At, B1); PG8_BAR;
            PG8_LDA(At, 0, 1); PG8_STAGE(PG8_SA(0, 0), a2, voffA);
            PG8_BAR; PG8_WAIT_L(0); PG8_MMA(1, 0, At, B0); PG8_BAR; PG8_SCHED;
            PG8_STAGE(PG8_SB(0, 1), b2 + hstep, voffB);
            PG8_WAIT_V(6); PG8_BAR; PG8_MMA(1, 1, At, B1); PG8_BAR;
            PG8_LDB(B0, 1, 0); PG8_SCHED; PG8_LDA(At, 1, 0); PG8_STAGE(PG8_SA(0, 1), a2 + hstep, voffA);
            PG8_WAIT_L(8); PG8_BAR; PG8_WAIT_L(0); PG8_MMA(0, 0, At, B0); PG8_BAR; PG8_SCHED;
            PG8_LDB(B1, 1, 1); PG8_STAGE(PG8_SB(1, 0), b3, voffB);
            PG8_BAR; PG8_WAIT_L(0); PG8_MMA(0, 1, At, B1); PG8_BAR;
            PG8_LDA(At, 1, 1); PG8_STAGE(PG8_SA(1, 0), a3, voffA);
            PG8_BAR; PG8_WAIT_L(0); PG8_MMA(1, 0, At, B0); PG8_BAR; PG8_SCHED;
            PG8_STAGE(PG8_SB(1, 1), b3 + hstep, voffB);
            PG8_WAIT_V(6); PG8_BAR; PG8_MMA(1, 1, At, B1); PG8_BAR;
            }
        }
        if constexpr (ALIGN_EPI) { if (wr == 0) PG8_BAR; }
        if constexpr (!Epi::AFTER_DRAIN) { E(acc, cur, wr, wc, fr, fq); S.done(cur); }
        if (!has_next) break;
#pragma unroll
        for (int a = 0; a < 2; ++a)
#pragma unroll
            for (int b = 0; b < 2; ++b)
#pragma unroll
                for (int m = 0; m < 4; ++m)
#pragma unroll
                    for (int n = 0; n < 2; ++n) acc[a][b][m][n] = (f32x4){0.f, 0.f, 0.f, 0.f};
        cur = nxt; cA = nA; cB = nB; ++ui;
        if constexpr (ALIGN_EPI) { if (wr == 1) PG8_BAR; }
    }
    PG8_WAIT_V(0);
    if constexpr (!ALIGN_EPI) { if (wr == 0) PG8_BAR; }
    PG8_BAR;
    if constexpr (Epi::AFTER_DRAIN) { E.fused(acc, cur, wr, wc, fr, fq, lds, wid, lane); S.done(cur); }
#undef PG8_SA
#undef PG8_SB
#undef PG8_STAGE
#undef PG8_LDA
#undef PG8_LDB
#undef PG8_MMA
#undef PG8_WAIT_V
#undef PG8_WAIT_L
#undef PG8_BAR
#undef PG8_SCHED
}
}
#ifndef MK_ONE_LAUNCH
#define MK_ONE_LAUNCH 1
#endif
#define LAS __attribute__((address_space(3)))
typedef unsigned short bf16;
typedef short bf16x8 __attribute__((ext_vector_type(8)));
typedef short bf16x4 __attribute__((ext_vector_type(4)));
typedef float f32x4 __attribute__((ext_vector_type(4)));
typedef unsigned u32x4 __attribute__((ext_vector_type(4)));
typedef unsigned u32x2 __attribute__((ext_vector_type(2)));

constexpr int NB = 4, SEQ = 4096, DM = 2048, NT = NB * SEQ, DEPTH = 4;
constexpr int EVEN_IN = 7176, EVEN_N = 7168, EVEN_LD = 7168, ODD_IN = 4096, DFF = 8192, XAW = 512, MEML = 256;
constexpr float EPS = 1e-6f;
constexpr float LOG2E = 1.4426950408889634f;
constexpr float QK_SCALE = 0.08838834764831845f;

constexpr size_t MiB = 1u << 20;
constexpr size_t WS_H = 1 * MiB;
constexpr size_t WS_XN = WS_H + 128 * MiB;
constexpr size_t WS_PROJ = WS_XN + 64 * MiB;
constexpr size_t WS_MIX = WS_PROJ + 256 * MiB;
constexpr size_t WS_VT = WS_MIX + 64 * MiB;
constexpr size_t WS_QX = WS_VT + 64 * MiB;
constexpr size_t WS_XO = WS_QX + 16 * MiB;
constexpr size_t WS_FLOG = WS_XO + 16 * MiB;
constexpr size_t WS_C2 = WS_FLOG + 1 * MiB;
constexpr size_t WS_MEMN = WS_C2 + 1 * MiB;
constexpr size_t WS_KVX = WS_MEMN + 4 * MiB;
constexpr size_t WS_VTX = WS_KVX + 8 * MiB;
constexpr size_t WS_ROPE = WS_VTX + 4 * MiB;
constexpr size_t WS_WKVT = WS_ROPE + 2 * MiB;
constexpr size_t WS_WINT = WS_WKVT + 16 * MiB;
constexpr size_t WS_WOUTT = WS_WINT + 30 * MiB;
constexpr size_t WS_WQT = WS_WOUTT + 8 * MiB;
constexpr size_t WS_WOT = WS_WQT + 2 * MiB;
constexpr size_t WS_W1T = WS_WOT + 2 * MiB;
constexpr size_t WS_W2T = WS_W1T + 32 * MiB;
constexpr size_t WS_WGLUT = WS_W2T + 32 * MiB;
constexpr size_t WS_SSQ = WS_WGLUT + 2 * MiB;
constexpr size_t WS_END = WS_SSQ + 2 * MiB;

constexpr int LDS_BYTES = 147456;

__device__ __forceinline__ unsigned f2bf(float f) { unsigned u = __builtin_bit_cast(unsigned, f); return (u + 0x7fffu + ((u >> 16) & 1u)) >> 16; }
__device__ __forceinline__ unsigned pk2(float lo, float hi) { unsigned r; asm("v_cvt_pk_bf16_f32 %0, %1, %2" : "=v"(r) : "v"(lo), "v"(hi)); return r; }
__device__ __forceinline__ float bflo(unsigned w) { return __uint_as_float(w << 16); }
__device__ __forceinline__ float bfhi(unsigned w) { return __uint_as_float(w & 0xffff0000u); }
__device__ __forceinline__ float wave_sum(float v) {
#pragma unroll
    for (int o = 1; o < 64; o <<= 1) v += __shfl_xor(v, o);
    return v;
}
#define LDS_FENCE() do { asm volatile("s_waitcnt lgkmcnt(0)" ::: "memory"); __builtin_amdgcn_wave_barrier(); } while (0)

struct Args { const float* in[27]; float* out; unsigned char* ws; int ph_lo, ph_hi; };

__device__ __forceinline__ void tr_load(f32x4 (&v)[8], const float* __restrict__ W, int ldw, int col0, int k0, int lane) {
#pragma unroll
    for (int i = 0; i < 8; ++i) v[i] = __builtin_nontemporal_load((const f32x4*)(W + (size_t)(k0 + i * 8 + (lane >> 3)) * ldw + col0 + 4 * (lane & 7)));
}
__device__ __forceinline__ void tr_store(const f32x4 (&v)[8], int K, bf16* __restrict__ WT, int drow0, int k0, LAS float* scr, int lane, const float* __restrict__ gain) {
    const int c4 = lane & 7, r8 = lane >> 3;
#pragma unroll
    for (int i = 0; i < 8; ++i) { const float gk = gain ? gain[k0 + i * 8 + r8] : 1.f; LAS float* d = scr + (i * 8 + r8) * 33 + 4 * c4; d[0] = v[i].x * gk; d[1] = v[i].y * gk; d[2] = v[i].z * gk; d[3] = v[i].w * gk; }
    LDS_FENCE();
    const int c = lane & 7;
#pragma unroll
    for (int j = 0; j < 4; ++j) { const int n = (lane >> 3) + 8 * j; const LAS float* s = scr + (8 * c) * 33 + n;
        u32x4 o; o.x = pk2(s[0 * 33], s[1 * 33]); o.y = pk2(s[2 * 33], s[3 * 33]); o.z = pk2(s[4 * 33], s[5 * 33]); o.w = pk2(s[6 * 33], s[7 * 33]);
        *(u32x4*)(WT + (size_t)(drow0 + n) * K + k0 + 8 * c) = o; }
    LDS_FENCE();
}
__device__ __forceinline__ void tr_matrix(const float* W, int ldw, int K, int col_off, int ncols, bf16* WT, int row_off, LAS float* scr, int gw, int NGW, int lane, int& base, const float* gain = nullptr) {
    const int nblk = ncols / 32, nitems = (K / 64) * nblk;
    int it = gw - (base % NGW); if (it < 0) it += NGW;
    base += nitems;
    f32x4 cur[8];
    if (it < nitems) { const int kb = it / nblk, nb = it - kb * nblk; tr_load(cur, W, ldw, col_off + 32 * nb, 64 * kb, lane); }
    while (it < nitems) {
        const int kb = it / nblk, nb = it - kb * nblk, nx = it + NGW;
        f32x4 nxt[8];
        if (nx < nitems) { const int kb2 = nx / nblk, nb2 = nx - kb2 * nblk; tr_load(nxt, W, ldw, col_off + 32 * nb2, 64 * kb2, lane); }
        tr_store(cur, K, WT, row_off + 32 * nb, 64 * kb, scr, lane, gain);
#pragma unroll
        for (int i = 0; i < 8; ++i) cur[i] = nxt[i];
        it = nx;
    }
}
__device__ __forceinline__ void rms_row(const float* __restrict__ xrow, const float* __restrict__ gain, bf16* orow, float* of32, const LAS f32x4* wfl, float* fl, int lane) {
    const f32x4* xr = (const f32x4*)xrow + lane; const f32x4* gr = (const f32x4*)gain + lane;
    f32x4 v[8]; float s = 0.f;
#pragma unroll
    for (int j = 0; j < 8; ++j) { v[j] = xr[64 * j]; s += (v[j].x * v[j].x + v[j].y * v[j].y) + (v[j].z * v[j].z + v[j].w * v[j].w); }
    const float r = rsqrtf(wave_sum(s) * (1.f / DM) + EPS);
#pragma unroll
    for (int j = 0; j < 8; ++j) v[j] = v[j] * r * gr[64 * j];
    if (of32) {
#pragma unroll
        for (int j = 0; j < 8; ++j) ((f32x4*)of32 + lane)[64 * j] = v[j];
    } else {
        u32x2* o8 = (u32x2*)orow + lane;
#pragma unroll
        for (int j = 0; j < 8; ++j) { u32x2 w; w.x = pk2(v[j].x, v[j].y); w.y = pk2(v[j].z, v[j].w); o8[64 * j] = w; }
    }
    if (fl) {
        f32x4 p0 = (f32x4){0.f, 0.f, 0.f, 0.f}, p1 = (f32x4){0.f, 0.f, 0.f, 0.f};
#pragma unroll
        for (int j = 0; j < 8; ++j)
#pragma unroll
            for (int e = 0; e < 4; ++e) { const f32x4 w0 = wfl[((j * 4 + e) * 2 + 0) * 64 + lane], w1 = wfl[((j * 4 + e) * 2 + 1) * 64 + lane]; p0 += w0 * v[j][e]; p1 += w1 * v[j][e]; }
#pragma unroll
        for (int e = 0; e < 4; ++e) { p0[e] = wave_sum(p0[e]); p1[e] = wave_sum(p1[e]); }
        if (lane == 0) { *(f32x4*)fl = p0; *(f32x4*)(fl + 4) = p1; }
    }
}
__device__ __forceinline__ void rms_rows(const float* X, const float* gain, bf16* O, float* OF, int nrows, int gw, int NGW, int lane, const LAS f32x4* wfl = nullptr, float* FL = nullptr) {
    for (int m = gw; m < nrows; m += NGW) rms_row(X + (size_t)m * DM, gain, O ? O + (size_t)m * DM : nullptr, OF ? OF + (size_t)m * DM : nullptr, wfl, FL ? FL + (size_t)m * 8 : nullptr, lane);
}

__device__ __forceinline__ void tr_bf16_64x64(const bf16* __restrict__ src, size_t lds_, bf16* __restrict__ dst, size_t ldd, LAS unsigned char* scr, int lane) {
#pragma unroll
    for (int i = 0; i < 8; ++i) { const int id = i * 64 + lane, r = id >> 3, ch = id & 7;
        const u32x4 v = *(const u32x4*)(src + (size_t)r * lds_ + ch * 8);
#pragma unroll
        for (int e = 0; e < 4; ++e) { const unsigned w = v[e]; const int c = ch * 8 + 2 * e;
            *(LAS unsigned short*)(scr + c * 144 + r * 2) = (unsigned short)(w & 0xffffu); *(LAS unsigned short*)(scr + (c + 1) * 144 + r * 2) = (unsigned short)(w >> 16); } }
    LDS_FENCE();
#pragma unroll
    for (int i = 0; i < 8; ++i) { const int id = i * 64 + lane, c = id >> 3, ch = id & 7;
        const u32x4 v = *(const LAS u32x4*)(scr + c * 144 + ch * 16);
        *(u32x4*)(dst + (size_t)c * ldd + ch * 8) = v; }
    LDS_FENCE();
}
constexpr int AT_KP = 272, AT_VP = 144, AT_KB = 64 * AT_KP, AT_VB = 128 * AT_VP;
constexpr int AT_VOFF = 2 * AT_KB;
template <int MODE>
__device__ __forceinline__ void attn_unit(LAS unsigned char* lds, const bf16* __restrict__ Qp, int ldq, const bf16* __restrict__ Kp, int ldk, const bf16* __restrict__ VTp, int ldvt,
                                          bf16* __restrict__ Op, int ldo, int q0, int nkeys, const float* __restrict__ c2, float l2g, const bf16* __restrict__ gate) {
    int tid_ = threadIdx.x; asm volatile("" : "+v"(tid_));
    const int tid = tid_, w = __builtin_amdgcn_readfirstlane(tid >> 6), lane = tid & 63, g4 = lane >> 4, c16 = lane & 15;
    const int ntiles = (MODE == 2) ? (nkeys >> 6) : ((q0 + 256) >> 6);
    const int qw0 = q0 + w * 32;
    const int tmax = (MODE == 2) ? ntiles - 1 : ((qw0 + 31) >> 6);
    __syncthreads();
    bf16x8 qf[2][4];
#pragma unroll
    for (int qs = 0; qs < 2; ++qs)
#pragma unroll
        for (int dk = 0; dk < 4; ++dk) qf[qs][dk] = *(const bf16x8*)(Qp + (size_t)(qw0 + qs * 16 + c16) * ldq + dk * 32 + g4 * 8);
    f32x4 dkf[4];
    if (MODE == 1) {
#pragma unroll
        for (int kb = 0; kb < 4; ++kb)
#pragma unroll
            for (int j = 0; j < 4; ++j) dkf[kb][j] = __builtin_amdgcn_exp2f(-l2g * (float)(kb * 16 + g4 * 4 + j));
    }
    const int kr0 = tid >> 4, kc = tid & 15;
    const int vr0 = tid >> 3, vc = tid & 7;
    u32x4 kreg[2], vreg[2];
#define AT_LOAD(t) do { \
        kreg[0] = *(const u32x4*)(Kp + (size_t)((t) * 64 + kr0) * ldk + kc * 8); kreg[1] = *(const u32x4*)(Kp + (size_t)((t) * 64 + kr0 + 32) * ldk + kc * 8); \
        vreg[0] = *(const u32x4*)(VTp + (size_t)vr0 * ldvt + (t) * 64 + vc * 8); vreg[1] = *(const u32x4*)(VTp + (size_t)(vr0 + 64) * ldvt + (t) * 64 + vc * 8); } while (0)
#define AT_STORE(b) do { \
        *(LAS u32x4*)(lds + (b) * AT_KB + kr0 * AT_KP + kc * 16) = kreg[0]; *(LAS u32x4*)(lds + (b) * AT_KB + (kr0 + 32) * AT_KP + kc * 16) = kreg[1]; \
        *(LAS u32x4*)(lds + AT_VOFF + (b) * AT_VB + vr0 * AT_VP + vc * 16) = vreg[0]; *(LAS u32x4*)(lds + AT_VOFF + (b) * AT_VB + (vr0 + 64) * AT_VP + vc * 16) = vreg[1]; } while (0)
    f32x4 O[8][2];
#pragma unroll
    for (int db = 0; db < 8; ++db) { O[db][0] = (f32x4){0.f, 0.f, 0.f, 0.f}; O[db][1] = (f32x4){0.f, 0.f, 0.f, 0.f}; }
    float mrun[2] = {-INFINITY, -INFINITY}, lsum[2] = {0.f, 0.f};
    AT_LOAD(0); AT_STORE(0);
    __syncthreads();
    for (int t = 0; t < ntiles; ++t) {
        const int cur = t & 1;
        if (t + 1 < ntiles) AT_LOAD(t + 1);
        if (t <= tmax) {
            const LAS unsigned char* Ks = lds + cur * AT_KB; const LAS unsigned char* Vs = lds + AT_VOFF + cur * AT_VB;
            f32x4 S[4][2];
#pragma unroll
            for (int kb = 0; kb < 4; ++kb) { S[kb][0] = (f32x4){0.f, 0.f, 0.f, 0.f}; S[kb][1] = (f32x4){0.f, 0.f, 0.f, 0.f};
#pragma unroll
                for (int dk = 0; dk < 4; ++dk) { const bf16x8 kf = *(const LAS bf16x8*)(Ks + (kb * 16 + c16) * AT_KP + dk * 64 + g4 * 16);
                    S[kb][0] = __builtin_amdgcn_mfma_f32_16x16x32_bf16(kf, qf[0][dk], S[kb][0], 0, 0, 0);
                    S[kb][1] = __builtin_amdgcn_mfma_f32_16x16x32_bf16(kf, qf[1][dk], S[kb][1], 0, 0, 0); } }
            const int kbase = t * 64 + g4 * 4;
            const bool diag = (MODE != 2) && (t * 64 + 63 > qw0);
            if (MODE == 1) {
#pragma unroll
                for (int qs = 0; qs < 2; ++qs) { const int qpos = qw0 + qs * 16 + c16;
                    const float dq = __builtin_amdgcn_exp2f(l2g * (float)(qpos - t * 64));
#pragma unroll
                    for (int kb = 0; kb < 4; ++kb)
#pragma unroll
                        for (int j = 0; j < 4; ++j) { float p = (S[kb][qs][j] * dq) * dkf[kb][j];
                            if (diag && (kbase + kb * 16 + j > qpos)) p = 0.f;
                            S[kb][qs][j] = p; } }
            } else {
                f32x4 ck[4];
                if (MODE == 0) {
#pragma unroll
                    for (int kb = 0; kb < 4; ++kb) ck[kb] = *(const f32x4*)(c2 + kbase + kb * 16);
                }
#pragma unroll
                for (int qs = 0; qs < 2; ++qs) { const int qpos = qw0 + qs * 16 + c16; float mx = -INFINITY;
#pragma unroll
                    for (int kb = 0; kb < 4; ++kb)
#pragma unroll
                        for (int j = 0; j < 4; ++j) { float s = S[kb][qs][j] * (QK_SCALE * LOG2E);
                            if (MODE == 0) { s -= ck[kb][j]; if (diag && (kbase + kb * 16 + j > qpos)) s = -INFINITY; }
                            S[kb][qs][j] = s; mx = fmaxf(mx, s); }
                    mx = fmaxf(mx, __shfl_xor(mx, 16)); mx = fmaxf(mx, __shfl_xor(mx, 32));
                    const float mnew = fmaxf(mrun[qs], mx);
                    const float alpha = __builtin_amdgcn_exp2f(mrun[qs] - mnew);
                    mrun[qs] = mnew; float ps = 0.f;
#pragma unroll
                    for (int kb = 0; kb < 4; ++kb)
#pragma unroll
                        for (int j = 0; j < 4; ++j) { const float p = __builtin_amdgcn_exp2f(S[kb][qs][j] - mnew); S[kb][qs][j] = p; ps += p; }
                    lsum[qs] = lsum[qs] * alpha + ps;
#pragma unroll
                    for (int db = 0; db < 8; ++db) O[db][qs] = O[db][qs] * alpha; }
            }
#pragma unroll
            for (int k2 = 0; k2 < 2; ++k2) {
                bf16x8 pb[2];
#pragma unroll
                for (int qs = 0; qs < 2; ++qs) { u32x4 pw; pw.x = pk2(S[2 * k2][qs][0], S[2 * k2][qs][1]); pw.y = pk2(S[2 * k2][qs][2], S[2 * k2][qs][3]);
                    pw.z = pk2(S[2 * k2 + 1][qs][0], S[2 * k2 + 1][qs][1]); pw.w = pk2(S[2 * k2 + 1][qs][2], S[2 * k2 + 1][qs][3]); pb[qs] = __builtin_bit_cast(bf16x8, pw); }
#pragma unroll
                for (int db = 0; db < 8; ++db) { const LAS unsigned char* vp = Vs + (db * 16 + c16) * AT_VP + k2 * 64 + g4 * 8;
                    const u32x2 v0 = *(const LAS u32x2*)vp, v1 = *(const LAS u32x2*)(vp + 32);
                    u32x4 vw; vw.x = v0.x; vw.y = v0.y; vw.z = v1.x; vw.w = v1.y; const bf16x8 vf = __builtin_bit_cast(bf16x8, vw);
                    O[db][0] = __builtin_amdgcn_mfma_f32_16x16x32_bf16(vf, pb[0], O[db][0], 0, 0, 0);
                    O[db][1] = __builtin_amdgcn_mfma_f32_16x16x32_bf16(vf, pb[1], O[db][1], 0, 0, 0); }
            }
        }
        if (t + 1 < ntiles) AT_STORE(cur ^ 1);
        __syncthreads();
    }
#undef AT_LOAD
#undef AT_STORE
#pragma unroll
    for (int qs = 0; qs < 2; ++qs) {
        if (MODE == 1) {
            float s = 0.f;
#pragma unroll
            for (int db = 0; db < 8; ++db) s += (O[db][qs][0] + O[db][qs][1]) + (O[db][qs][2] + O[db][qs][3]);
            s += __shfl_xor(s, 16); s += __shfl_xor(s, 32);
            const float mu = s * (1.f / 128.f); float q = 0.f;
#pragma unroll
            for (int db = 0; db < 8; ++db) { O[db][qs] = O[db][qs] - mu; q += (O[db][qs][0] * O[db][qs][0] + O[db][qs][1] * O[db][qs][1]) + (O[db][qs][2] * O[db][qs][2] + O[db][qs][3] * O[db][qs][3]); }
            q += __shfl_xor(q, 16); q += __shfl_xor(q, 32);
            const float rs = rsqrtf(q * (1.f / 128.f) + EPS);
#pragma unroll
            for (int db = 0; db < 8; ++db) O[db][qs] = O[db][qs] * rs;
        } else {
            float l = lsum[qs]; l += __shfl_xor(l, 16); l += __shfl_xor(l, 32);
            const float inv = 1.f / l;
#pragma unroll
            for (int db = 0; db < 8; ++db) O[db][qs] = O[db][qs] * inv;
        }
    }
    LAS unsigned char* Os = lds + w * (32 * AT_KP);
#pragma unroll
    for (int qs = 0; qs < 2; ++qs)
#pragma unroll
        for (int db = 0; db < 8; ++db) { u32x2 wv; wv.x = pk2(O[db][qs][0], O[db][qs][1]); wv.y = pk2(O[db][qs][2], O[db][qs][3]);
            *(LAS u32x2*)(Os + (qs * 16 + c16) * AT_KP + (db * 16 + g4 * 4) * 2) = wv; }
    LDS_FENCE();
#pragma unroll
    for (int i = 0; i < 8; ++i) { const int id = i * 64 + lane, r = id >> 4, ch = id & 15;
        u32x4 v = *(const LAS u32x4*)(Os + r * AT_KP + ch * 16);
        if (MODE == 1) { const u32x4 gv = *(const u32x4*)(gate + (size_t)(qw0 + r) * ldq + ch * 8);
#pragma unroll
            for (int e = 0; e < 4; ++e) { const float g0 = bflo(gv[e]), g1 = bfhi(gv[e]);
                const float o0 = bflo(v[e]) * (g0 / (1.f + __expf(-g0))), o1 = bfhi(v[e]) * (g1 / (1.f + __expf(-g1))); v[e] = pk2(o0, o1); } }
        *(u32x4*)(Op + (size_t)(qw0 + r) * ldo + ch * 8) = v; }
}
constexpr int S5_BUP = 80;
constexpr int S5_WAVE = 128 * S5_BUP + 16 * 272;
constexpr int S5_XCH = 8 * S5_WAVE;
struct S5P { const float *a_re, *a_im, *b_re, *b_im, *c_re, *c_im, *dsk, *lstep; };
__device__ __forceinline__ void s5_abar(const S5P& P, int g, int p, float& ar, float& ai, float& cr, float& ci) {
    const float lr = fminf(P.a_re[g * 64 + p], -1e-4f), li = P.a_im[g * 64 + p], st = __expf(P.lstep[g * 64 + p]);
    const float zr = lr * st, zi = li * st, mag = __expf(zr);
    const float rev = zi * 0.15915494309189535f; const float fr = rev - floorf(rev);
    ar = mag * __builtin_amdgcn_cosf(fr); ai = mag * __builtin_amdgcn_sinf(fr);
    const float nr = ar - 1.f, ni = ai, den = 1.f / (lr * lr + li * li);
    cr = (nr * lr + ni * li) * den; ci = (ni * lr - nr * li) * den;
}
__device__ __forceinline__ float gelu_tanh(float y) {
    const float u = 0.7978845608028654f * (y + 0.044715f * y * y * y);
    const float t = __builtin_amdgcn_exp2f(u * (2.f * LOG2E));
    const float th = 1.f - 2.f / (t + 1.f);
    return 0.5f * y * (1.f + th);
}
__device__ __forceinline__ void s5_unit(LAS unsigned char* lds, int b, int g, const bf16* __restrict__ PROJ, bf16* __restrict__ GB, const S5P& P) {
    int tid_ = threadIdx.x; asm volatile("" : "+v"(tid_));
    const int tid = tid_, w = __builtin_amdgcn_readfirstlane(tid >> 6), lane = tid & 63, g4 = lane >> 4, c16 = lane & 15;
    LAS unsigned char* Bs = lds + w * S5_WAVE; LAS unsigned char* Xs = Bs + 128 * S5_BUP; LAS float* xch = (LAS float*)(lds + S5_XCH);
    __syncthreads();
    float ar, ai, tcr, tci; s5_abar(P, g, lane, ar, ai, tcr, tci);
    bf16x8 Bb[8];
#pragma unroll
    for (int q = 0; q < 4; ++q) { const int pp = q * 16 + c16; float a0, a1, cr, ci; s5_abar(P, g, pp, a0, a1, cr, ci);
        unsigned wr_[4], wi_[4];
#pragma unroll
        for (int e = 0; e < 4; ++e) { float re[2], im[2];
#pragma unroll
            for (int h = 0; h < 2; ++h) { const int c = (g4 & 1) * 8 + 2 * e + h; const float br = P.b_re[((size_t)g * 64 + pp) * 16 + c], bi = P.b_im[((size_t)g * 64 + pp) * 16 + c];
                re[h] = cr * br - ci * bi; im[h] = cr * bi + ci * br; }
            wr_[e] = (g4 < 2) ? pk2(re[0], re[1]) : 0u; wi_[e] = (g4 < 2) ? pk2(im[0], im[1]) : 0u; }
        u32x4 a; a.x = wr_[0]; a.y = wr_[1]; a.z = wr_[2]; a.w = wr_[3]; Bb[q] = __builtin_bit_cast(bf16x8, a);
        u32x4 c; c.x = wi_[0]; c.y = wi_[1]; c.z = wi_[2]; c.w = wi_[3]; Bb[4 + q] = __builtin_bit_cast(bf16x8, c); }
    bf16x8 Cb[4];
#pragma unroll
    for (int kb = 0; kb < 4; ++kb) { unsigned wv[4];
#pragma unroll
        for (int e = 0; e < 4; ++e) { const int pidx = kb * 16 + g4 * 4 + e; const size_t ix = ((size_t)g * 16 + c16) * 64 + pidx; wv[e] = pk2(P.c_re[ix], -P.c_im[ix]); }
        u32x4 a; a.x = wv[0]; a.y = wv[1]; a.z = wv[2]; a.w = wv[3]; Cb[kb] = __builtin_bit_cast(bf16x8, a); }
    const float dsk = P.dsk[g * 16 + c16];
    const bf16* urow = PROJ + (size_t)(b * SEQ) * ODD_IN + g * 16;
    float xr = 0.f, xi = 0.f;
    for (int pass = 0; pass < 2; ++pass) {
        u32x4 uw = (u32x4){0u, 0u, 0u, 0u}; unsigned short us[4] = {0, 0, 0, 0};
        { const int tok0 = w * 512;
          if (g4 < 2) uw = *(const u32x4*)(urow + (size_t)(tok0 + c16) * ODD_IN + g4 * 8);
          if (pass == 1) {
#pragma unroll
              for (int j = 0; j < 4; ++j) us[j] = urow[(size_t)(tok0 + g4 * 4 + j) * ODD_IN + c16]; } }
        for (int blk = 0; blk < 32; ++blk) {
            const int tok0 = w * 512 + blk * 16;
            u32x4 uwn = (u32x4){0u, 0u, 0u, 0u}; unsigned short usn[4] = {0, 0, 0, 0};
            if (blk + 1 < 32) { const int tok1 = tok0 + 16;
                if (g4 < 2) uwn = *(const u32x4*)(urow + (size_t)(tok1 + c16) * ODD_IN + g4 * 8);
                if (pass == 1) {
#pragma unroll
                    for (int j = 0; j < 4; ++j) usn[j] = urow[(size_t)(tok1 + g4 * 4 + j) * ODD_IN + c16]; } }
            const bf16x8 ua = __builtin_bit_cast(bf16x8, uw);
#pragma unroll
            for (int nb = 0; nb < 8; ++nb) { f32x4 acc = (f32x4){0.f, 0.f, 0.f, 0.f};
                acc = __builtin_amdgcn_mfma_f32_16x16x32_bf16(ua, Bb[nb], acc, 0, 0, 0);
                *(LAS f32x4*)(Bs + (nb * 16 + c16) * S5_BUP + g4 * 16) = acc; }
            __syncthreads();
#pragma unroll
            for (int k = 0; k < 4; ++k) { const f32x4 br = *(const LAS f32x4*)(Bs + lane * S5_BUP + k * 16), bi = *(const LAS f32x4*)(Bs + (64 + lane) * S5_BUP + k * 16);
#pragma unroll
                for (int j = 0; j < 4; ++j) { const float nr = ar * xr - ai * xi + br[j], ni = ar * xi + ai * xr + bi[j]; xr = nr; xi = ni;
                    if (pass == 1) *(LAS unsigned*)(Xs + (k * 4 + j) * 272 + lane * 4) = pk2(xr, xi); } }
            if (pass == 1) {
                __syncthreads();
                f32x4 y = (f32x4){0.f, 0.f, 0.f, 0.f};
#pragma unroll
                for (int kb = 0; kb < 4; ++kb) { const bf16x8 xa = *(const LAS bf16x8*)(Xs + c16 * 272 + kb * 64 + g4 * 16); y = __builtin_amdgcn_mfma_f32_16x16x32_bf16(xa, Cb[kb], y, 0, 0, 0); }
#pragma unroll
                for (int j = 0; j < 4; ++j) { const int tok = tok0 + g4 * 4 + j; const float u = __uint_as_float((unsigned)us[j] << 16);
                    const float v = gelu_tanh(y[j] + dsk * u);
                    GB[(size_t)(b * SEQ + tok) * 1024 + g * 16 + c16] = (bf16)f2bf(v); }
            }
            __syncthreads();
            uw = uwn;
#pragma unroll
            for (int j = 0; j < 4; ++j) us[j] = usn[j];
        }
        if (pass == 0) {
            xch[(w * 64 + lane) * 2] = xr; xch[(w * 64 + lane) * 2 + 1] = xi;
            __syncthreads();
            float pr = ar, pi = ai;
#pragma unroll
            for (int s = 0; s < 9; ++s) { const float nr = pr * pr - pi * pi, ni = 2.f * pr * pi; pr = nr; pi = ni; }
            xr = 0.f; xi = 0.f;
            for (int j = 0; j < w; ++j) { const float er = xch[(j * 64 + lane) * 2], ei = xch[(j * 64 + lane) * 2 + 1];
                const float nr = pr * xr - pi * xi + er, ni = pr * xi + pi * xr + ei; xr = nr; xi = ni; }
        }
    }
}
#define x_in IN(0)
#define H ((float*)(ws + WS_H))
#define XN ((bf16*)(ws + WS_XN))
#define PROJ ((bf16*)(ws + WS_PROJ))
#define MIX ((bf16*)(ws + WS_MIX))
#define VT ((bf16*)(ws + WS_VT))
#define GB ((bf16*)(ws + WS_VT))
#define QX ((bf16*)(ws + WS_QX))
#define XO ((bf16*)(ws + WS_XO))
#define FLOG ((float*)(ws + WS_FLOG))
#define C2 ((float*)(ws + WS_C2))
#define MEMN ((bf16*)(ws + WS_MEMN))
#define KVX ((bf16*)(ws + WS_KVX))
#define VTX ((bf16*)(ws + WS_VTX))
#define ROPE ((float*)(ws + WS_ROPE))
#define WKVT ((bf16*)(ws + WS_WKVT))
#define WINT ((bf16*)(ws + WS_WINT))
#define WOUTT ((bf16*)(ws + WS_WOUTT))
#define WQT ((bf16*)(ws + WS_WQT))
#define WOT ((bf16*)(ws + WS_WOT))
#define W1T ((bf16*)(ws + WS_W1T))
#define W2T ((bf16*)(ws + WS_W2T))
#define WGLUT ((bf16*)(ws + WS_WGLUT))
#define SSQ ((float*)(ws + WS_SSQ))
#define IN(i) ((const float*)(const __attribute__((address_space(1))) float*)(unsigned long long)(args.in[(i) + zz]))
#define run_gemm(lds, ...) run_gemm_(lds, G, bid, __VA_ARGS__)
constexpr int PH_PER_LAYER = 10, N_PHASES = DEPTH * PH_PER_LAYER + 1;
using GOrder = pg8::StaticOrder;
template <class Epi> __device__ __forceinline__ void run_gemm_(LAS unsigned char* lds, int G, int bid, const bf16* A, const bf16* Bt, int M, int N, int K, const Epi& E) {
    pg8::Gemm g{A, Bt, M, N, K}; GOrder S; S.init(M, N, G, bid);
#ifndef NO_GEMM
    pg8::gemm_phase<Epi, GOrder, true, true>(lds, g, S, E);
#endif
}

#define RLX_AGENT __ATOMIC_RELAXED, __HIP_MEMORY_SCOPE_AGENT
#define XB_TMO      128
#define XB_XCNT(j)  (256  + 64 * (j))
#define XB_XSUB(j)  (1280 + 64 * (j))
#define XB_XGEN(j)  (2304 + 64 * (j))
#define XB_TOP      3328
#define XB_TOPGEN   3392
#define XCD_BAR_WORDS 3456
#define XB_SPIN_CAP (1u << 23)

__device__ __forceinline__ unsigned xb_ld(unsigned* p)              { return __hip_atomic_load(p, __ATOMIC_RELAXED, __HIP_MEMORY_SCOPE_AGENT); }
__device__ __forceinline__ unsigned xb_add(unsigned* p, unsigned v) { return __hip_atomic_fetch_add(p, v, __ATOMIC_RELAXED, __HIP_MEMORY_SCOPE_AGENT); }
__device__ __forceinline__ unsigned xb_xcc_id() { return (unsigned)__builtin_amdgcn_s_getreg((3 << 11) | 20) & 0xFu; }
#define XB_SPIN(cond, bar) do { unsigned _sp = 0; while (cond) { __builtin_amdgcn_s_sleep(1); \
    if ((++_sp & 255u) == 0u) { if (xb_ld(&(bar)[XB_TMO])) break; if (_sp > XB_SPIN_CAP) { atomicAdd(&(bar)[XB_TMO], 1u); break; } } } } while (0)

struct XcdBarrier {
    unsigned* bar; unsigned x;
    volatile LAS unsigned* st;
};

__device__ __forceinline__ XcdBarrier xcd_barrier_post(unsigned* bar, volatile LAS unsigned* st) {
    XcdBarrier b; b.bar = bar; b.x = xb_xcc_id(); b.st = st;
    if (threadIdx.x == 0) (void)xb_add(&bar[XB_XCNT(b.x)], 1u);
    return b;
}
__device__ __forceinline__ void xcd_barrier_complete(unsigned* bar, unsigned x, unsigned& nloc, unsigned& nx) {
    const unsigned G = gridDim.x * gridDim.y * gridDim.z;
    unsigned sum, cnt, mine, sp = 0u;
    for (;;) {
        sum = 0u; cnt = 0u; mine = 0u;
#pragma unroll
        for (unsigned j = 0; j < 16; ++j) { const unsigned c = xb_ld(&bar[XB_XCNT(j)]); sum += c; cnt += (c > 0u) ? 1u : 0u; mine = (j == x) ? c : mine; }
        if (sum == G) break;
        __builtin_amdgcn_s_sleep(1);
        if ((++sp & 255u) == 0u) { if (xb_ld(&bar[XB_TMO])) break; if (sp > XB_SPIN_CAP) { atomicAdd(&bar[XB_TMO], 1u); break; } }
    }
    nloc = mine > 0u ? mine : 1u; nx = cnt > 0u ? cnt : 1u;
}

__device__ __forceinline__ void xcd_barrier(const XcdBarrier& b) {
    asm volatile("s_waitcnt vmcnt(0)" ::: "memory");
    __syncthreads();
    if (threadIdx.x == 0) {
        unsigned* bar = b.bar;
        __builtin_amdgcn_s_waitcnt(0);
        unsigned nloc = b.st[0], nx = b.st[1];
        if (nloc == 0u) { xcd_barrier_complete(bar, b.x, nloc, nx); b.st[0] = nloc; b.st[1] = nx; }
        const unsigned old = xb_add(&bar[XB_XSUB(b.x)], 1u);
        const unsigned gen = old / nloc;
        if (old + 1u == (gen + 1u) * nloc) {
            __builtin_amdgcn_fence(__ATOMIC_RELEASE, "agent");
            asm volatile("s_waitcnt vmcnt(0)" ::: "memory");
            const unsigned og = xb_add(&bar[XB_TOP], 1u);
            const unsigned tg = og / nx;
            if (og + 1u == (tg + 1u) * nx) xb_add(&bar[XB_TOPGEN], 1u);
            else XB_SPIN(xb_ld(&bar[XB_TOPGEN]) == tg, bar);
            __builtin_amdgcn_fence(__ATOMIC_ACQUIRE, "agent");
            xb_add(&bar[XB_XGEN(b.x)], 1u);
            asm volatile("s_waitcnt vmcnt(0)" ::: "memory");
        } else {
            XB_SPIN(xb_ld(&bar[XB_XGEN(b.x)]) == gen, bar);
            __builtin_amdgcn_fence(__ATOMIC_ACQUIRE, "agent");
            asm volatile("s_waitcnt vmcnt(0)" ::: "memory");
        }
    }
    __syncthreads();
}

__device__ __forceinline__ void grid_bar(unsigned* cnt, unsigned target) {
#ifdef DBG_DELAY
    { const unsigned long long t0 = __builtin_amdgcn_s_memrealtime(); while (__builtin_amdgcn_s_memrealtime() - t0 < (unsigned long long)DBG_DELAY) __builtin_amdgcn_s_sleep(8); }
#endif
    asm volatile("s_waitcnt vmcnt(0) lgkmcnt(0)" ::: "memory");
    __syncthreads();
    if (threadIdx.x == 0) {
        __builtin_amdgcn_fence(__ATOMIC_RELEASE, "");
        asm volatile("s_waitcnt vmcnt(0)" ::: "memory");
        __hip_atomic_fetch_add(cnt, 1u, __ATOMIC_RELAXED, __HIP_MEMORY_SCOPE_AGENT);
        while (__hip_atomic_load(cnt, __ATOMIC_RELAXED, __HIP_MEMORY_SCOPE_AGENT) < target) __builtin_amdgcn_s_sleep(1);
        __builtin_amdgcn_fence(__ATOMIC_ACQUIRE, "");
        asm volatile("s_waitcnt vmcnt(0)" ::: "memory");
    }
    __syncthreads();
}
__global__ void __launch_bounds__(512, 2) trunk_fwd(Args args) {
    extern __shared__ __attribute__((aligned(16))) unsigned char lds_raw[];
    LAS unsigned char* lds = (LAS unsigned char*)lds_raw;
    cg::grid_group grid = cg::this_grid();
    const int lo = args.ph_lo, hi = args.ph_hi;
    int ph = 0; unsigned nbar = 0; (void)nbar;
    if (threadIdx.x < 2) ((volatile LAS unsigned*)(lds + LDS_BYTES - 64))[threadIdx.x] = 0u;
    __syncthreads();
    XcdBarrier xbar = xcd_barrier_post((unsigned*)args.ws, (volatile LAS unsigned*)(lds + LDS_BYTES - 64));
#ifdef DBG_LDSFILL
    for (int i = threadIdx.x; i < LDS_BYTES / 16; i += 512) ((LAS u32x4*)lds)[i] = (u32x4){0u, 0u, 0u, 0u};
    __syncthreads();
#endif
#ifdef DBG_FILL
    { u32x4* p = (u32x4*)(args.ws + MiB); const size_t n = (WS_END - MiB) / 16; for (size_t i = (size_t)blockIdx.x * 512 + threadIdx.x; i < n; i += (size_t)gridDim.x * 512) p[i] = (u32x4){0u, 0u, 0u, 0u}; }
#endif
    if (hi - lo > 1) grid.sync();
#ifndef DBG_NPH
#define DBG_NPH 1000
#endif
#define PH_BEGIN if (ph >= lo && ph < hi && (ph < DBG_NPH || ph == N_PHASES - 1)) { __attribute__((address_space(1))) unsigned char* ws = (__attribute__((address_space(1))) unsigned char*)(unsigned long long)args.ws; int zz = 0; int tid = threadIdx.x; int G = gridDim.x; int bid = blockIdx.x; asm volatile("" : "+s"(ws), "+s"(zz), "+v"(tid), "+s"(G), "+s"(bid)); const int lane = tid & 63, wave = __builtin_amdgcn_readfirstlane(tid >> 6), gw = bid * 8 + wave, NGW = G * 8; (void)lane; (void)gw; (void)NGW;
#ifdef DBG_DUP_BAR
#define PH_END } if (ph >= lo && ph + 1 < hi) { ++nbar; grid_bar((unsigned*)args.ws, nbar * gridDim.x); ++nbar; grid_bar((unsigned*)args.ws, nbar * gridDim.x); } ++ph;
#else
#define PH_END } if (ph >= lo && ph + 1 < hi) { xcd_barrier(xbar); } ++ph;
#endif

#ifdef DBG_COPYX
    { const float* xs = args.in[0]; for (size_t i = (size_t)blockIdx.x * 512 + threadIdx.x; i < (size_t)NT * DM; i += (size_t)gridDim.x * 512) args.out[i] = xs[i]; return; }
#endif
#ifdef DBG_BARTEST
    { float* flag = (float*)(args.ws + 512 * 1024);
      if (blockIdx.x == 5) { const unsigned long long t0 = __builtin_amdgcn_s_memrealtime(); while (__builtin_amdgcn_s_memrealtime() - t0 < 300000ull) __builtin_amdgcn_s_sleep(8);
          if (threadIdx.x == 0) flag[0] = 1234.5f; }
#if DBG_BARTEST == 1
      ++nbar; grid_bar((unsigned*)args.ws, nbar * gridDim.x);
#else
      grid.sync();
#endif
      const float f = __hip_atomic_load(flag, __ATOMIC_RELAXED, __HIP_MEMORY_SCOPE_AGENT);
      for (size_t i = (size_t)blockIdx.x * 512 + threadIdx.x; i < (size_t)NT * DM; i += (size_t)gridDim.x * 512) args.out[i] = f;
      return; }
#endif
#pragma unroll 1
    for (int layer = 0; layer < DEPTH; ++layer) {
        const bool even = (layer & 1) == 0;
#ifdef DBG_SUB0
        const int sub = 0;
#else
        const int sub = layer >> 1;
#endif
        PH_BEGIN
            LAS float* scr = (LAS float*)(lds + wave * 16384); int tbase = 0;
#ifdef DBG_DUP_A
            for (int rep = 0; rep < 2; ++rep) {
#endif
            if (layer == 0) {
                rms_rows(IN(1), IN(5), MEMN, nullptr, NB * MEML, gw, NGW, lane);
                for (int l = 0; l < DEPTH; ++l) tr_matrix(IN(23) + (size_t)l * DM * 1024, 1024, DM, 0, 1024, WKVT, l * 1024, scr, gw, NGW, lane, tbase);
                for (int idx = bid * 512 + tid; idx < SEQ * 64; idx += G * 512) { const int pos = idx >> 6, i = idx & 63;
                    const float inv = powf(10000.f, -(float)i * (1.f / 64.f)); const float ang = (float)pos * inv;
                    const double rev = (double)ang * 0.15915494309189535; const float fr = (float)(rev - floor(rev));
                    ROPE[idx] = __builtin_amdgcn_cosf(fr); ROPE[SEQ * 64 + idx] = __builtin_amdgcn_sinf(fr); }
            }
            if (even) {
                const float* Win = IN(7) + (size_t)sub * DM * EVEN_IN;
                tr_matrix(Win, EVEN_IN, DM, 0, 3072, WINT, 0, scr, gw, NGW, lane, tbase);
                tr_matrix(Win, EVEN_IN, DM, 3080, 4096, WINT, 3072, scr, gw, NGW, lane, tbase);
                tr_matrix(IN(9) + (size_t)sub * DM * DM, DM, DM, 0, DM, WOUTT, 0, scr, gw, NGW, lane, tbase);
            } else {
                tr_matrix(IN(10) + (size_t)sub * DM * ODD_IN, ODD_IN, DM, 0, ODD_IN, WINT, 0, scr, gw, NGW, lane, tbase, IN(2) + layer * DM);
                tr_matrix(IN(19) + (size_t)sub * 1024 * 1024, 1024, 1024, 0, 1024, WGLUT, 0, scr, gw, NGW, lane, tbase);
                tr_matrix(IN(21) + (size_t)sub * DM * DM, DM, DM, 0, DM, WOUTT, 0, scr, gw, NGW, lane, tbase);
            }
            tr_matrix(IN(22) + (size_t)layer * DM * XAW, XAW, DM, 0, XAW, WQT, 0, scr, gw, NGW, lane, tbase, IN(3) + layer * DM);
            tr_matrix(IN(24) + (size_t)layer * XAW * DM, DM, XAW, 0, DM, WOT, 0, scr, gw, NGW, lane, tbase);
            tr_matrix(IN(25) + (size_t)layer * DM * DFF, DFF, DM, 0, DFF, W1T, 0, scr, gw, NGW, lane, tbase, IN(4) + layer * DM);
            tr_matrix(IN(26) + (size_t)layer * DFF * DM, DM, DFF, 0, DM, W2T, 0, scr, gw, NGW, lane, tbase);
            if (even) {
                __syncthreads();
                const float* wf = IN(7) + (size_t)sub * DM * EVEN_IN + 3072; LAS f32x4* wfl = (LAS f32x4*)lds;
                for (int i = tid; i < 4096; i += 512) { const int k = i >> 1, half = i & 1; wfl[((((k >> 8) * 4 + (k & 3)) * 2 + half) * 64) + ((k >> 2) & 63)] = *(const f32x4*)(wf + (size_t)k * EVEN_IN + half * 4); }
                __syncthreads();
                rms_rows((layer == 0) ? x_in : H, IN(2) + layer * DM, XN, nullptr, NT, gw, NGW, lane, wfl, FLOG);
            }
#ifdef DBG_DUP_A
            }
#endif
        PH_END
        PH_BEGIN
            if (even) { pg8::EpiBf E{PROJ, EVEN_LD, 0, nullptr, -1, nullptr}; run_gemm(lds, XN, WINT, NT, EVEN_N, DM, E); }
#ifdef DBG_TWICE
            if (layer == 2) { pg8::EpiBf E2{MIX, DM, 0, nullptr, -1, nullptr}; run_gemm(lds, XN, WINT, NT, DM, DM, E2); }
#endif
            else { pg8::EpiBf E{PROJ, ODD_IN, 0, nullptr, -1, SSQ}; run_gemm(lds, XN, WINT, NT, ODD_IN, DM, E); }
            if (layer == 0) { pg8::EpiBf E{KVX, 4096, 0, nullptr, -1, nullptr}; run_gemm(lds, MEMN, WKVT, NB * MEML, 4096, DM, E); }
        PH_END
        if (even) {
            PH_BEGIN
                if (bid < 32) {
                    const int b = bid >> 3, h = bid & 7; const float bias = IN(8)[sub * 8 + h];
                    float v[8]; float run = 0.f;
#pragma unroll
                    for (int e = 0; e < 8; ++e) { const float xx = FLOG[(size_t)(b * SEQ + tid * 8 + e) * 8 + h] + bias;
                        const float ls = fminf(xx, 0.f) - log1pf(__expf(-fabsf(xx))); run += ls; v[e] = run; }
                    float inc = run;
#pragma unroll
                    for (int o = 1; o < 64; o <<= 1) { const float t = __shfl_up(inc, o); if (lane >= o) inc += t; }
                    LAS float* wsum = (LAS float*)(lds + 131072);
                    __syncthreads();
                    if (lane == 63) wsum[wave] = inc;
                    __syncthreads();
                    float off = inc - run;
                    for (int j = 0; j < wave; ++j) off += wsum[j];
#pragma unroll
                    for (int e = 0; e < 8; ++e) C2[(size_t)(b * 8 + h) * SEQ + tid * 8 + e] = (v[e] + off) * LOG2E;
                }
                for (int t = gw; t < NT; t += NGW) { const int pos = t & (SEQ - 1), slot = lane >> 2, i0 = (lane & 3) * 16;
                    bf16* p1 = PROJ + (size_t)t * EVEN_LD + 3072 + slot * 128 + i0; bf16* p2 = p1 + 64;
                    const float sc = (slot >= 8) ? QK_SCALE : 1.f;
#pragma unroll
                    for (int hlf = 0; hlf < 2; ++hlf) { const u32x4 a = *(const u32x4*)(p1 + hlf * 8), c = *(const u32x4*)(p2 + hlf * 8); u32x4 o1, o2;
#pragma unroll
                        for (int e = 0; e < 4; ++e) { const int ii = i0 + hlf * 8 + 2 * e;
                            const float c0 = ROPE[pos * 64 + ii], c1 = ROPE[pos * 64 + ii + 1], s0 = ROPE[SEQ * 64 + pos * 64 + ii], s1 = ROPE[SEQ * 64 + pos * 64 + ii + 1];
                            const float a0 = bflo(a[e]), a1 = bfhi(a[e]), b0 = bflo(c[e]), b1 = bfhi(c[e]);
                            o1[e] = pk2((a0 * c0 - b0 * s0) * sc, (a1 * c1 - b1 * s1) * sc); o2[e] = pk2((a0 * s0 + b0 * c0) * sc, (a1 * s1 + b1 * c1) * sc); }
                        *(u32x4*)(p1 + hlf * 8) = o1; *(u32x4*)(p2 + hlf * 8) = o2; } }
                { LAS unsigned char* scr = lds + wave * 9216;
                  for (int it = gw; it < NB * 16 * 64 * 2; it += NGW) { const int dh = it & 1, tb = (it >> 1) & 63, h16 = (it >> 7) & 15, b = it >> 11;
                      const bf16* src = PROJ + (size_t)(b * SEQ + tb * 64) * EVEN_LD + (h16 < 8 ? 2048 + h16 * 128 : 5120 + (h16 - 8) * 128) + dh * 64;
                      bf16* dst = VT + ((size_t)(b * 16 + h16) * 128 + dh * 64) * SEQ + tb * 64;
                      tr_bf16_64x64(src, EVEN_LD, dst, SEQ, scr, lane); }
                  if (layer == 0) for (int it = gw; it < DEPTH * NB * 4 * 4 * 2; it += NGW) { const int dh = it & 1, kb = (it >> 1) & 3, h = (it >> 3) & 3, b = (it >> 5) & 3, l = it >> 7;
                      const bf16* src = KVX + (size_t)(b * MEML + kb * 64) * 4096 + l * 1024 + 512 + h * 128 + dh * 64;
                      bf16* dst = VTX + ((size_t)((l * NB + b) * 4 + h) * 128 + dh * 64) * MEML + kb * 64;
                      tr_bf16_64x64(src, 4096, dst, MEML, scr, lane); } }
            PH_END
            PH_BEGIN
                const int NU = NB * 16 * 16;
#ifdef DBG_DUP_ATTN
                for (int rep = 0; rep < 2; ++rep)
#endif
                for (int r = 0; r * G < NU; ++r) { const int sidx = r * G + ((r & 1) ? (G - 1 - bid) : bid); if (sidx >= NU) continue;
                    const int qb = 15 - (sidx >> 6), bh = sidx & 63, b = bh >> 4, h16 = bh & 15, h = h16 & 7;
                    const bf16* rowb = PROJ + (size_t)(b * SEQ) * EVEN_LD; const bf16* vt = VT + (size_t)(b * 16 + h16) * 128 * SEQ; bf16* ob = MIX + (size_t)(b * SEQ) * DM;
#ifndef NO_ATTN
                    if (h16 < 8) attn_unit<0>(lds, rowb + h * 128, EVEN_LD, rowb + 1024 + h * 128, EVEN_LD, vt, SEQ, ob + h * 128, DM, qb * 256, 0, C2 + (size_t)(b * 8 + h) * SEQ, 0.f, nullptr);
                    else { const float l2g = log2f(1.f - exp2f(-5.f - (float)h));
                        attn_unit<1>(lds, rowb + 3072 + h * 128, EVEN_LD, rowb + 4096 + h * 128, EVEN_LD, vt, SEQ, ob + 1024 + h * 128, DM, qb * 256, 0, nullptr, l2g, rowb + 6144 + h * 128); }
#endif
                }
            PH_END
        } else {
            PH_BEGIN
#ifdef DBG_DUP_S5
                for (int rep = 0; rep < 2; ++rep) {
#endif
                S5P P{IN(11) + sub * 4096, IN(12) + sub * 4096, IN(13) + (size_t)sub * 65536, IN(14) + (size_t)sub * 65536,
                      IN(15) + (size_t)sub * 65536, IN(16) + (size_t)sub * 65536, IN(17) + sub * 1024, IN(18) + sub * 4096};
#ifndef NO_S5
                for (int u = bid; u < NB * 64; u += G) s5_unit(lds, u >> 6, u & 63, PROJ, GB, P);
#endif
                const float* cw = IN(20) + sub * 3 * 1024;
                for (int idx = bid * 512 + tid; idx < NT * 128; idx += G * 512) { const int tok = idx >> 7, ch = (idx & 127) * 8, l = tok & (SEQ - 1);
                    const bf16* row = PROJ + (size_t)tok * ODD_IN;
                    float acc[8];
#pragma unroll
                    for (int e = 0; e < 8; ++e) acc[e] = 0.f;
#pragma unroll
                    for (int k = 0; k < 3; ++k) { const int back = 2 - k; if (l - back < 0) continue;
                        const u32x4 hv = *(const u32x4*)(row - (size_t)back * ODD_IN + 1024 + ch), gc = *(const u32x4*)(row - (size_t)back * ODD_IN + 3072 + ch);
                        const f32x4 w0 = *(const f32x4*)(cw + k * 1024 + ch), w1 = *(const f32x4*)(cw + k * 1024 + ch + 4);
#pragma unroll
                        for (int e = 0; e < 4; ++e) { const float wa = (e < 2) ? w0[2 * e] : w1[2 * e - 4], wb = (e < 2) ? w0[2 * e + 1] : w1[2 * e - 3];
                            acc[2 * e] += wa * (bflo(hv[e]) * bflo(gc[e])); acc[2 * e + 1] += wb * (bfhi(hv[e]) * bfhi(gc[e])); } }
                    const u32x4 gb = *(const u32x4*)(row + 2048 + ch); u32x4 o;
#pragma unroll
                    for (int e = 0; e < 4; ++e) o[e] = pk2(bflo(gb[e]) * acc[2 * e], bfhi(gb[e]) * acc[2 * e + 1]);
                    *(u32x4*)(MIX + (size_t)tok * DM + 1024 + ch) = o; }
#ifdef DBG_DUP_S5
                }
#endif
            PH_END
            PH_BEGIN
                pg8::EpiGlu E{GB, 1024, MIX, DM}; run_gemm(lds, GB, WGLUT, NT, 1024, 1024, E);
            PH_END
        }
        PH_BEGIN
            pg8::EpiResid E{(layer == 0) ? x_in : H, H, DM, XN, SSQ}; run_gemm(lds, MIX, WOUTT, NT, DM, DM, E);
        PH_END
        PH_BEGIN
            pg8::EpiBf E{QX, XAW, 0, nullptr, -1, SSQ}; run_gemm(lds, XN, WQT, NT, XAW, DM, E);
        PH_END
        PH_BEGIN
            for (int u = bid; u < NB * 4 * 16; u += G) { const int qb = u & 15, h = (u >> 4) & 3, b = u >> 6;
#ifndef NO_XATTN
                attn_unit<2>(lds, QX + (size_t)(b * SEQ) * XAW + h * 128, XAW, KVX + (size_t)(b * MEML) * 4096 + layer * 1024 + h * 128, 4096,
                             VTX + (size_t)((layer * NB + b) * 4 + h) * 128 * MEML, MEML, XO + (size_t)(b * SEQ) * XAW + h * 128, XAW, qb * 256, MEML, nullptr, 0.f, nullptr);
#endif
            }
        PH_END
        PH_BEGIN
            pg8::EpiResid E{H, H, DM, XN, SSQ}; run_gemm(lds, XO, WOT, NT, DM, XAW, E);
        PH_END
        PH_BEGIN
#ifndef DBG_SKIPMLP
            pg8::EpiBf E{PROJ, DFF, 1, nullptr, -1, SSQ}; run_gemm(lds, XN, W1T, NT, DFF, DM, E);
#endif
        PH_END
        PH_BEGIN
#ifndef DBG_SKIPMLP
            pg8::EpiResid E{H, H, DM, even ? XN : nullptr, even ? SSQ : nullptr}; run_gemm(lds, PROJ, W2T, NT, DM, DFF, E);
#endif
        PH_END
    }
    PH_BEGIN
#ifdef DBG_OUTBUF
        { const bf16* src = (const bf16*)(ws + DBG_OUTBUF); for (size_t i = (size_t)bid * 512 + tid; i < (size_t)NT * DM; i += (size_t)G * 512) { const size_t t = i >> 11, c = i & 2047; float v = __uint_as_float((unsigned)src[t * DBG_OUTLD + DBG_OUTCOL + c] << 16);
#ifdef DBG_TWICE
            v -= __uint_as_float((unsigned)MIX[t * DM + c] << 16);
#endif
            args.out[i] = v; } }
#else
        rms_rows(H, IN(6), nullptr, args.out, NT, gw, NGW, lane);
#endif
    PH_END
#undef PH_BEGIN
#undef PH_END
}
#undef H
#undef XN
#undef PROJ
#undef MIX
#undef VT
#undef GB
#undef QX
#undef XO
#undef IN
#undef x_in

extern "C" void kernel_launch(void* const* d_in, const int* in_sizes, int n_in, void* d_out, int out_size, void* d_ws, size_t ws_size, hipStream_t stream) {
    static int grid = 0;
    if (grid == 0) {
        if (n_in != 27 || out_size != NT * DM || ws_size < WS_END) { fprintf(stderr, "kernel_launch: unexpected problem (n_in %d out %d ws %zu, need %zu)\n", n_in, out_size, ws_size, (size_t)WS_END); grid = -1; return; }
        int dev = 0, cus = 0, per_cu = 0;
        hipGetDevice(&dev); hipDeviceGetAttribute(&cus, hipDeviceAttributeMultiprocessorCount, dev);
        if (hipFuncSetAttribute((const void*)trunk_fwd, hipFuncAttributeMaxDynamicSharedMemorySize, LDS_BYTES) != hipSuccess) { fprintf(stderr, "kernel_launch: hipFuncSetAttribute failed\n"); grid = -1; return; }
        hipOccupancyMaxActiveBlocksPerMultiprocessor(&per_cu, (const void*)trunk_fwd, 512, LDS_BYTES);
        if (per_cu < 1) { fprintf(stderr, "kernel_launch: occupancy query says %d blocks/CU\n", per_cu); per_cu = 1; }
        (void)hipGetLastError();
        grid = cus * 1;
    }
    if (grid < 0) return;
    (void)hipMemsetAsync(d_ws, 0, 16384, stream);
    Args a{};
    for (int i = 0; i < 27; ++i) a.in[i] = (const float*)d_in[i];
    a.out = (float*)d_out; a.ws = (unsigned char*)d_ws;
#if MK_ONE_LAUNCH
    a.ph_lo = 0; a.ph_hi = N_PHASES;
    { void* kargs[] = {&a}; hipError_t e = hipLaunchCooperativeKernel((const void*)trunk_fwd, dim3(grid), dim3(512), kargs, LDS_BYTES, stream);
      if (e != hipSuccess) fprintf(stderr, "cooperative launch failed: %s (grid %d)\n", hipGetErrorString(e), grid); }
#else
    for (int p = 0; p < N_PHASES; ++p) { a.ph_lo = p; a.ph_hi = p + 1;
        void* kargs[] = {&a}; hipError_t e = hipLaunchCooperativeKernel((const void*)trunk_fwd, dim3(grid), dim3(512), kargs, LDS_BYTES, stream);
        if (e != hipSuccess) { fprintf(stderr, "launch %d failed: %s (grid %d)\n", p, hipGetErrorString(e), grid); break; } }
#endif
}
```

```cpp
#include <hip/hip_runtime.h>
#include <hip/hip_cooperative_groups.h>
#include <cstdio>
#include <cstdint>
namespace cg = cooperative_groups;
#ifndef PG8_AUX
#define PG8_AUX 0
#endif
namespace pg8 {
#define PG8_LAS __attribute__((address_space(3)))
typedef unsigned short bf16_t;
typedef short bf16x8 __attribute__((ext_vector_type(8)));
typedef float f32x4 __attribute__((ext_vector_type(4)));
typedef unsigned u32x4 __attribute__((ext_vector_type(4)));
constexpr int BM = 256, BK = 64, HALF = 128, HTB = HALF * BK * 2  , STAGE_BYTES = 8 * HTB, NXCD = 8, WGM = 8;

__host__ __device__ __forceinline__ int lds_byte(int r, int c) { const int st = (r >> 4) * 2 + (c >> 5), rr = r & 15, cc = c & 31, ob = rr * 64 + cc * 2; return st * 1024 + (ob ^ (((ob >> 9) & 1) << 5)); }
__host__ __device__ __forceinline__ void stage_rc(int b, int& R, int& C) { const int st = b / 1024, sb = b % 1024, swz = sb ^ (((sb >> 9) & 1) << 5); R = (st >> 1) * 16 + swz / 64; C = (st & 1) * 32 + (swz % 64) / 2; }
__host__ __device__ __forceinline__ int perm32(int rho) { const int n = rho >> 4, i = rho & 15; return 8 * (i >> 2) + 4 * n + (i & 3); }

struct Unit { int pm, pn; };
struct Gemm { const bf16_t* A; const bf16_t* Bt; int M, N, K; };

struct StaticOrder {
    int nM, nN, nwg, G, c;
    __host__ __device__ void init(int M, int N, int G_, int c_) { nM = M / BM; nN = N / BM; nwg = nM * nN; G = G_; c = c_; }
    __host__ __device__ bool next(int i, Unit& u) const {
        const long L = (long)i * G + c; if (L >= nwg) return false;
        int wgid = (int)L; { const int q = nwg / NXCD, r = nwg % NXCD, xcd = wgid % NXCD, off = wgid / NXCD; wgid = (xcd < r ? xcd * (q + 1) : r * (q + 1) + (xcd - r) * q) + off; }
        const int nig = WGM * nN, gid = wgid / nig, fm = gid * WGM, gsz = (nM - fm) < WGM ? (nM - fm) : WGM;
        u.pm = fm + ((wgid % nig) % gsz); u.pn = (wgid % nig) / gsz; return true;
    }
    __device__ __forceinline__ void a_ready(const Unit&) const {}
    __device__ __forceinline__ void done(const Unit&) const {}
};

__device__ __forceinline__ unsigned cvt_pk_bf16(float lo, float hi) { unsigned r; asm volatile("v_cvt_pk_bf16_f32 %0, %1, %2" : "=v"(r) : "v"(lo), "v"(hi)); return r; }
struct EpiBf {
    static constexpr bool PERM = true, AFTER_DRAIN = false;
    bf16_t* O; int ldc; int act; float* flog; int flog_tile; const float* ssq;
    __device__ __forceinline__ void operator()(const f32x4 (&acc)[2][2][4][2], const Unit& u, int wr, int wc, int fr, int fq) const {
        const int row0 = u.pm * BM + wr * 64 + fr;
        if (u.pn == flog_tile) {
            if (wc == 0 && fq == 0) {
#pragma unroll
                for (int ai = 0; ai < 2; ++ai)
#pragma unroll
                    for (int m = 0; m < 4; ++m) { float* p = flog + (size_t)(row0 + ai * HALF + m * 16) * 8; *(f32x4*)p = acc[ai][0][m][0]; *(f32x4*)(p + 4) = acc[ai][0][m][1]; }
            }
            return;
        }
        const int col0 = u.pn * BM + wc * 32 + 8 * fq;
#pragma unroll
        for (int ai = 0; ai < 2; ++ai)
#pragma unroll
            for (int m = 0; m < 4; ++m) { bf16_t* rowp = O + (size_t)(row0 + ai * HALF + m * 16) * ldc + col0;
                float rs = 1.f;
                if (ssq) { const f32x4* sp = (const f32x4*)(ssq + (size_t)(row0 + ai * HALF + m * 16) * 32) + fq * 2; const f32x4 a = sp[0], b = sp[1];
                    float s = ((a.x + a.y) + (a.z + a.w)) + ((b.x + b.y) + (b.z + b.w)); s += __shfl_xor(s, 16); s += __shfl_xor(s, 32); rs = rsqrtf(s * (1.f / 2048.f) + 1e-6f); }
#pragma unroll
                for (int bj = 0; bj < 2; ++bj) { f32x4 v0 = acc[ai][bj][m][0] * rs, v1 = acc[ai][bj][m][1] * rs;
                    if (act) {
#pragma unroll
                        for (int e = 0; e < 4; ++e) { float a = fmaxf(v0[e], 0.f), b = fmaxf(v1[e], 0.f); v0[e] = a * a; v1[e] = b * b; } }
                    u32x4 w; w.x = cvt_pk_bf16(v0[0], v0[1]); w.y = cvt_pk_bf16(v0[2], v0[3]); w.z = cvt_pk_bf16(v1[0], v1[1]); w.w = cvt_pk_bf16(v1[2], v1[3]);
                    *(u32x4*)(rowp + bj * HALF) = w; } }
    }
};
struct EpiResid {
    static constexpr bool PERM = true, AFTER_DRAIN = false;
    const float* base; float* out; int ldc; bf16_t* xb; float* ssq;
    __device__ __forceinline__ void operator()(const f32x4 (&acc)[2][2][4][2], const Unit& u, int wr, int wc, int fr, int fq) const {
        const int col0 = u.pn * BM + wc * 32 + 8 * fq;
#pragma unroll
        for (int ai = 0; ai < 2; ++ai) {
            f32x4 bs[4][2][2];
#pragma unroll
            for (int m = 0; m < 4; ++m) { const size_t off = (size_t)(u.pm * BM + ai * HALF + wr * 64 + m * 16 + fr) * ldc + col0;
#pragma unroll
                for (int bj = 0; bj < 2; ++bj) { bs[m][bj][0] = *(const f32x4*)(base + off + bj * HALF); bs[m][bj][1] = *(const f32x4*)(base + off + bj * HALF + 4); } }
#pragma unroll
            for (int m = 0; m < 4; ++m) { const int row = u.pm * BM + ai * HALF + wr * 64 + m * 16 + fr; const size_t off = (size_t)row * ldc + col0; float s = 0.f;
#pragma unroll
                for (int bj = 0; bj < 2; ++bj) { const f32x4 o0 = bs[m][bj][0] + acc[ai][bj][m][0], o1 = bs[m][bj][1] + acc[ai][bj][m][1];
                    *(f32x4*)(out + off + bj * HALF) = o0; *(f32x4*)(out + off + bj * HALF + 4) = o1;
                    if (xb) { s += ((o0.x * o0.x + o0.y * o0.y) + (o0.z * o0.z + o0.w * o0.w)) + ((o1.x * o1.x + o1.y * o1.y) + (o1.z * o1.z + o1.w * o1.w));
                        u32x4 w; w.x = cvt_pk_bf16(o0.x, o0.y); w.y = cvt_pk_bf16(o0.z, o0.w); w.z = cvt_pk_bf16(o1.x, o1.y); w.w = cvt_pk_bf16(o1.z, o1.w);
                        *(u32x4*)(xb + off + bj * HALF) = w; } }
                if (xb) { s += __shfl_xor(s, 16); s += __shfl_xor(s, 32); if (fq == 0) ssq[(size_t)row * 32 + u.pn * 4 + wc] = s; } }
            asm volatile("" ::: "memory"); }
    }
};
struct EpiGlu {
    static constexpr bool PERM = true, AFTER_DRAIN = false;
    const bf16_t* Gm; int ldg; bf16_t* O; int ldc;
    __device__ __forceinline__ void operator()(const f32x4 (&acc)[2][2][4][2], const Unit& u, int wr, int wc, int fr, int fq) const {
        const int row0 = u.pm * BM + wr * 64 + fr, col0 = u.pn * BM + wc * 32 + 8 * fq;
#pragma unroll
        for (int ai = 0; ai < 2; ++ai)
#pragma unroll
            for (int m = 0; m < 4; ++m) { const size_t r = (size_t)(row0 + ai * HALF + m * 16);
#pragma unroll
                for (int bj = 0; bj < 2; ++bj) { const u32x4 gv = *(const u32x4*)(Gm + r * ldg + col0 + bj * HALF);
                    const f32x4 v0 = acc[ai][bj][m][0], v1 = acc[ai][bj][m][1]; float o[8];
#pragma unroll
                    for (int e = 0; e < 4; ++e) { const unsigned w = gv[e]; const float g0 = __uint_as_float(w << 16), g1 = __uint_as_float(w & 0xffff0000u);
                        const float a0 = (e < 2) ? v0[2 * e] : v1[2 * e - 4], a1 = (e < 2) ? v0[2 * e + 1] : v1[2 * e - 3];
                        o[2 * e] = g0 / (1.f + __expf(-a0)); o[2 * e + 1] = g1 / (1.f + __expf(-a1)); }
                    u32x4 w; w.x = cvt_pk_bf16(o[0], o[1]); w.y = cvt_pk_bf16(o[2], o[3]); w.z = cvt_pk_bf16(o[4], o[5]); w.w = cvt_pk_bf16(o[6], o[7]);
                    *(u32x4*)(O + r * ldc + col0 + bj * HALF) = w; }
                asm volatile("" ::: "memory"); }
    }
};
template <class Epi, class Sched, bool ALIGN_EPI = false, bool SP2 = false>
__device__ __forceinline__ void gemm_phase(PG8_LAS unsigned char* lds, const Gemm g, const Sched& S, const Epi& E) {
    int tid_ = threadIdx.x; asm volatile("" : "+v"(tid_));
    const int tid = tid_, wid = __builtin_amdgcn_readfirstlane(tid >> 6), lane = tid & 63, wr = wid >> 2, wc = wid & 3, fr = lane & 15, fq = lane >> 4;
    const int K = g.K, nt = K / BK;
    unsigned voffA[2], voffB[2];
#pragma unroll
    for (int i = 0; i < 2; ++i) { int R, C; stage_rc(tid * 16 + i * 8192, R, C); const int Rb = Epi::PERM ? ((R & ~31) + perm32(R & 31)) : R;
        voffA[i] = (unsigned)(R * K + C) * 2u; voffB[i] = (unsigned)(Rb * K + C) * 2u; }
    const size_t kstep = (size_t)(BK * 2);
    const size_t hstep = (size_t)HALF * K * 2;
    const size_t tstep = 2 * hstep;
    const unsigned ldsw = (unsigned)wid * 1024u;
    const int aoff = lds_byte(wr * 64 + fr, fq * 8), boff = lds_byte(wc * 32 + fr, fq * 8);
#define PG8_SA(b, h) (((b) * 2 + (h)) * HTB)
#define PG8_SB(b, h) ((4 + (b) * 2 + (h)) * HTB)
#define PG8_STAGE(bufoff, gbase, voff) do { _Pragma("unroll") for (int _i = 0; _i < 2; ++_i) \
        __builtin_amdgcn_global_load_lds((const unsigned*)((const char*)(gbase) + (voff)[_i]), (PG8_LAS unsigned*)(lds + (bufoff) + ldsw + _i * 8192), 16, 0, PG8_AUX); } while (0)
#define PG8_LDA(dst, b, h) do { _Pragma("unroll") for (int m = 0; m < 4; ++m) _Pragma("unroll") for (int k = 0; k < 2; ++k) dst[m][k] = *(const PG8_LAS bf16x8*)(lds + PG8_SA(b, h) + aoff + m * 2048 + k * 1024); } while (0)
#define PG8_LDB(dst, b, h) do { _Pragma("unroll") for (int n = 0; n < 2; ++n) _Pragma("unroll") for (int k = 0; k < 2; ++k) dst[n][k] = *(const PG8_LAS bf16x8*)(lds + PG8_SB(b, h) + boff + n * 2048 + k * 1024); } while (0)
#define PG8_MMA(ai, bj, At, Bt) do { __builtin_amdgcn_s_setprio(1); _Pragma("unroll") for (int m = 0; m < 4; ++m) _Pragma("unroll") for (int n = 0; n < 2; ++n) _Pragma("unroll") for (int k = 0; k < 2; ++k) \
        acc[ai][bj][m][n] = __builtin_amdgcn_mfma_f32_16x16x32_bf16(Bt[n][k], At[m][k], acc[ai][bj][m][n], 0, 0, 0); __builtin_amdgcn_s_setprio(0); } while (0)
#ifdef DBG_DRAIN
#define PG8_WAIT_V(n) asm volatile("s_waitcnt vmcnt(0)" ::: "memory")
#else
#define PG8_WAIT_V(n) asm volatile("s_waitcnt vmcnt(" #n ")" ::: "memory")
#endif
#define PG8_WAIT_L(n) asm volatile("s_waitcnt lgkmcnt(" #n ")" ::: "memory")
#define PG8_BAR __builtin_amdgcn_s_barrier()
#define PG8_SCHED __builtin_amdgcn_sched_barrier(0)
    Unit cur, nxt; int ui = 0;
    if (!S.next(0, cur)) return;
    f32x4 acc[2][2][4][2];
#pragma unroll
    for (int a = 0; a < 2; ++a)
#pragma unroll
        for (int b = 0; b < 2; ++b)
#pragma unroll
            for (int m = 0; m < 4; ++m)
#pragma unroll
                for (int n = 0; n < 2; ++n) acc[a][b][m][n] = (f32x4){0.f, 0.f, 0.f, 0.f};
    bf16x8 At[4][2], B0[2][2], B1[2][2];
    const char* cA = (const char*)g.A + (size_t)cur.pm * tstep; const char* cB = (const char*)g.Bt + (size_t)cur.pn * tstep;
    S.a_ready(cur);
    if constexpr (SP2) {
        PG8_STAGE(PG8_SB(0, 0), cB, voffB); PG8_STAGE(PG8_SB(0, 1), cB + hstep, voffB); PG8_STAGE(PG8_SA(0, 0), cA, voffA); PG8_STAGE(PG8_SA(0, 1), cA + hstep, voffA);
        if (wr == 1) PG8_BAR;
        PG8_WAIT_V(2); PG8_BAR;
        PG8_STAGE(PG8_SB(1, 0), cB + kstep, voffB); PG8_STAGE(PG8_SA(1, 0), cA + kstep, voffA); PG8_STAGE(PG8_SB(1, 1), cB + hstep + kstep, voffB);
        PG8_WAIT_V(6); PG8_BAR;
    } else {
        PG8_STAGE(PG8_SB(0, 0), cB, voffB); PG8_STAGE(PG8_SA(0, 0), cA, voffA); PG8_STAGE(PG8_SB(0, 1), cB + hstep, voffB); PG8_STAGE(PG8_SA(0, 1), cA + hstep, voffA);
        if (wr == 1) PG8_BAR;
        PG8_WAIT_V(4); PG8_BAR;
        PG8_STAGE(PG8_SB(1, 0), cB + kstep, voffB); PG8_STAGE(PG8_SA(1, 0), cA + kstep, voffA); PG8_STAGE(PG8_SB(1, 1), cB + hstep + kstep, voffB);
        PG8_WAIT_V(6); PG8_BAR;
    }
    for (;;) {
        const bool has_next = S.next(ui + 1, nxt);
        const char* nA = has_next ? (const char*)g.A + (size_t)nxt.pm * tstep : cA; const char* nB = has_next ? (const char*)g.Bt + (size_t)nxt.pn * tstep : cB;
        for (int t = 0; t < nt; t += 2) {
            const bool last = (t == nt - 2);
            const char* a1 = cA + (size_t)(t + 1) * kstep;
            const char* a2 = last ? nA : cA + (size_t)(t + 2) * kstep; const char* b2 = last ? nB : cB + (size_t)(t + 2) * kstep;
            const char* a3 = a2 + kstep; const char* b3 = b2 + kstep;
            if (last && has_next) S.a_ready(nxt);
            if constexpr (SP2) {
            PG8_LDB(B0, 0, 0); PG8_LDB(B1, 0, 1); PG8_SCHED; PG8_LDA(At, 0, 0); PG8_STAGE(PG8_SA(1, 1), a1 + hstep, voffA);
            PG8_WAIT_V(8); PG8_WAIT_L(0); PG8_BAR; PG8_MMA(0, 0, At, B0); PG8_MMA(0, 1, At, B1); PG8_BAR; PG8_SCHED;
            PG8_LDA(At, 0, 1); PG8_STAGE(PG8_SB(0, 0), b2, voffB); PG8_STAGE(PG8_SB(0, 1), b2 + hstep, voffB); PG8_STAGE(PG8_SA(0, 0), a2, voffA);
            PG8_WAIT_V(8); PG8_WAIT_L(0); PG8_BAR; PG8_MMA(1, 0, At, B0); PG8_MMA(1, 1, At, B1); PG8_BAR; PG8_SCHED;
            PG8_LDB(B0, 1, 0); PG8_LDB(B1, 1, 1); PG8_SCHED; PG8_LDA(At, 1, 0); PG8_STAGE(PG8_SA(0, 1), a2 + hstep, voffA);
            PG8_WAIT_V(8); PG8_WAIT_L(0); PG8_BAR; PG8_MMA(0, 0, At, B0); PG8_MMA(0, 1, At, B1); PG8_BAR; PG8_SCHED;
            PG8_LDA(At, 1, 1); PG8_STAGE(PG8_SB(1, 0), b3, voffB); PG8_STAGE(PG8_SB(1, 1), b3 + hstep, voffB); PG8_STAGE(PG8_SA(1, 0), a3, voffA);
            PG8_WAIT_V(8); PG8_WAIT_L(0); PG8_BAR; PG8_MMA(1, 0, At, B0); PG8_MMA(1, 1, At, B1); PG8_BAR; PG8_SCHED;
            } else {
            PG8_LDB(B0, 0, 0); PG8_SCHED; PG8_LDA(At, 0, 0); PG8_STAGE(PG8_SA(1, 1), a1 + hstep, voffA);
            PG8_WAIT_L(8); PG8_BAR; PG8_WAIT_L(0); PG8_MMA(0, 0, At, B0); PG8_BAR; PG8_SCHED;
            PG8_LDB(B1, 0, 1); PG8_STAGE(PG8_SB(0, 0), b2, voffB);
            PG8_BAR; PG8_WAIT_L(0); PG8_MMA(0, 1, At, B1); PG8_BAR;
            PG8_LDA(At, 0, 1); PG8_STAGE(PG8_SA(0, 0), a2, voffA);
            PG8_BAR; PG8_WAIT_L(0); PG8_MMA(1, 0, At, B0); PG8_BAR; PG8_SCHED;
            PG8_STAGE(PG8_SB(0, 1), b2 + hstep, voffB);
            PG8_WAIT_V(6); PG8_BAR; PG8_MMA(1, 1, At, B1); PG8_BAR;
            PG8_LDB(B0, 1, 0); PG8_SCHED; PG8_LDA(At, 1, 0); PG8_STAGE(PG8_SA(0, 1), a2 + hstep, voffA);
            PG8_WAIT_L(8); PG8_BAR; PG8_WAIT_L(0); PG8_MMA(0, 0, At, B0); PG8_BAR; PG8_SCHED;
            PG8_LDB(B1, 1, 1); PG8_STAGE(PG8_SB(1, 0), b3, voffB);
            PG8_BAR; PG8_WAIT_L(0); PG8_MMA(0, 1, At, B1); PG8_BAR;
            PG8_LDA(At, 1, 1); PG8_STAGE(PG8_SA(1, 0), a3, voffA);
            PG8_BAR; PG8_WAIT_L(0); PG8_MMA(1, 0, At, B0); PG8_BAR; PG8_SCHED;
            PG8_STAGE(PG8_SB(1, 1), b3 + hstep, voffB);
            PG8_WAIT_V(6); PG8_BAR; PG8_MMA(1, 1, At, B1); PG8_BAR;
            }
        }
        if constexpr (ALIGN_EPI) { if (wr == 0) PG8_BAR; }
        if constexpr (!Epi::AFTER_DRAIN) { E(acc, cur, wr, wc, fr, fq); S.done(cur); }
        if (!has_next) break;
#pragma unroll
        for (int a = 0; a < 2; ++a)
#pragma unroll
            for (int b = 0; b < 2; ++b)
#pragma unroll
                for (int m = 0; m < 4; ++m)
#pragma unroll
                    for (int n = 0; n < 2; ++n) acc[a][b][m][n] = (f32x4){0.f, 0.f, 0.f, 0.f};
        cur = nxt; cA = nA; cB = nB; ++ui;
        if constexpr (ALIGN_EPI) { if (wr == 1) PG8_BAR; }
    }
    PG8_WAIT_V(0);
    if constexpr (!ALIGN_EPI) { if (wr == 0) PG8_BAR; }
    PG8_BAR;
    if constexpr (Epi::AFTER_DRAIN) { E.fused(acc, cur, wr, wc, fr, fq, lds, wid, lane); S.done(cur); }
#undef PG8_SA
#undef PG8_SB
#undef PG8_STAGE
#undef PG8_LDA
#undef PG8_LDB
#undef PG8_MMA
#undef PG8_WAIT_V
#undef PG8_WAIT_L
#undef PG8_BAR
#undef PG8_SCHED
}
}
#ifndef MK_ONE_LAUNCH
#define MK_ONE_LAUNCH 1
#endif
#define LAS __attribute__((address_space(3)))
typedef unsigned short bf16;
typedef short bf16x8 __attribute__((ext_vector_type(8)));
typedef short bf16x4 __attribute__((ext_vector_type(4)));
typedef float f32x4 __attribute__((ext_vector_type(4)));
typedef unsigned u32x4 __attribute__((ext_vector_type(4)));
typedef unsigned u32x2 __attribute__((ext_vector_type(2)));

constexpr int NB = 4, SEQ = 4096, DM = 2048, NT = NB * SEQ, DEPTH = 4;
constexpr int EVEN_IN = 7176, EVEN_N = 7168, EVEN_LD = 7168, ODD_IN = 4096, DFF = 8192, XAW = 512, MEML = 256;
constexpr float EPS = 1e-6f;
constexpr float LOG2E = 1.4426950408889634f;
constexpr float QK_SCALE = 0.08838834764831845f;

constexpr size_t MiB = 1u << 20;
constexpr size_t WS_H = 1 * MiB;
constexpr size_t WS_XN = WS_H + 128 * MiB;
constexpr size_t WS_PROJ = WS_XN + 64 * MiB;
constexpr size_t WS_MIX = WS_PROJ + 256 * MiB;
constexpr size_t WS_VT = WS_MIX + 64 * MiB;
constexpr size_t WS_QX = WS_VT + 64 * MiB;
constexpr size_t WS_XO = WS_QX + 16 * MiB;
constexpr size_t WS_FLOG = WS_XO + 16 * MiB;
constexpr size_t WS_C2 = WS_FLOG + 1 * MiB;
constexpr size_t WS_MEMN = WS_C2 + 1 * MiB;
constexpr size_t WS_KVX = WS_MEMN + 4 * MiB;
constexpr size_t WS_VTX = WS_KVX + 8 * MiB;
constexpr size_t WS_ROPE = WS_VTX + 4 * MiB;
constexpr size_t WS_WKVT = WS_ROPE + 2 * MiB;
constexpr size_t WS_WINT = WS_WKVT + 16 * MiB;
constexpr size_t WS_WOUTT = WS_WINT + 30 * MiB;
constexpr size_t WS_WQT = WS_WOUTT + 8 * MiB;
constexpr size_t WS_WOT = WS_WQT + 2 * MiB;
constexpr size_t WS_W1T = WS_WOT + 2 * MiB;
constexpr size_t WS_W2T = WS_W1T + 32 * MiB;
constexpr size_t WS_WGLUT = WS_W2T + 32 * MiB;
constexpr size_t WS_SSQ = WS_WGLUT + 2 * MiB;
constexpr size_t WS_END = WS_SSQ + 2 * MiB;

constexpr int LDS_BYTES = 147456;

__device__ __forceinline__ unsigned f2bf(float f) { unsigned u = __builtin_bit_cast(unsigned, f); return (u + 0x7fffu + ((u >> 16) & 1u)) >> 16; }
__device__ __forceinline__ unsigned pk2(float lo, float hi) { unsigned r; asm("v_cvt_pk_bf16_f32 %0, %1, %2" : "=v"(r) : "v"(lo), "v"(hi)); return r; }
__device__ __forceinline__ float bflo(unsigned w) { return __uint_as_float(w << 16); }
__device__ __forceinline__ float bfhi(unsigned w) { return __uint_as_float(w & 0xffff0000u); }
__device__ __forceinline__ float wave_sum(float v) {
#pragma unroll
    for (int o = 1; o < 64; o <<= 1) v += __shfl_xor(v, o);
    return v;
}
#define LDS_FENCE() do { asm volatile("s_waitcnt lgkmcnt(0)" ::: "memory"); __builtin_amdgcn_wave_barrier(); } while (0)

struct Args { const float* in[27]; float* out; unsigned char* ws; int ph_lo, ph_hi; };

__device__ __forceinline__ void tr_load(f32x4 (&v)[8], const float* __restrict__ W, int ldw, int col0, int k0, int lane) {
#pragma unroll
    for (int i = 0; i < 8; ++i) v[i] = __builtin_nontemporal_load((const f32x4*)(W + (size_t)(k0 + i * 8 + (lane >> 3)) * ldw + col0 + 4 * (lane & 7)));
}
__device__ __forceinline__ void tr_store(const f32x4 (&v)[8], int K, bf16* __restrict__ WT, int drow0, int k0, LAS float* scr, int lane, const float* __restrict__ gain) {
    const int c4 = lane & 7, r8 = lane >> 3;
#pragma unroll
    for (int i = 0; i < 8; ++i) { const float gk = gain ? gain[k0 + i * 8 + r8] : 1.f; LAS float* d = scr + (i * 8 + r8) * 33 + 4 * c4; d[0] = v[i].x * gk; d[1] = v[i].y * gk; d[2] = v[i].z * gk; d[3] = v[i].w * gk; }
    LDS_FENCE();
    const int c = lane & 7;
#pragma unroll
    for (int j = 0; j < 4; ++j) { const int n = (lane >> 3) + 8 * j; const LAS float* s = scr + (8 * c) * 33 + n;
        u32x4 o; o.x = pk2(s[0 * 33], s[1 * 33]); o.y = pk2(s[2 * 33], s[3 * 33]); o.z = pk2(s[4 * 33], s[5 * 33]); o.w = pk2(s[6 * 33], s[7 * 33]);
        *(u32x4*)(WT + (size_t)(drow0 + n) * K + k0 + 8 * c) = o; }
    LDS_FENCE();
}
__device__ __forceinline__ void tr_matrix(const float* W, int ldw, int K, int col_off, int ncols, bf16* WT, int row_off, LAS float* scr, int gw, int NGW, int lane, int& base, const float* gain = nullptr) {
    const int nblk = ncols / 32, nitems = (K / 64) * nblk;
    int it = gw - (base % NGW); if (it < 0) it += NGW;
    base += nitems;
    f32x4 cur[8];
    if (it < nitems) { const int kb = it / nblk, nb = it - kb * nblk; tr_load(cur, W, ldw, col_off + 32 * nb, 64 * kb, lane); }
    while (it < nitems) {
        const int kb = it / nblk, nb = it - kb * nblk, nx = it + NGW;
        f32x4 nxt[8];
        if (nx < nitems) { const int kb2 = nx / nblk, nb2 = nx - kb2 * nblk; tr_load(nxt, W, ldw, col_off + 32 * nb2, 64 * kb2, lane); }
        tr_store(cur, K, WT, row_off + 32 * nb, 64 * kb, scr, lane, gain);
#pragma unroll
        for (int i = 0; i < 8; ++i) cur[i] = nxt[i];
        it = nx;
    }
}
__device__ __forceinline__ void rms_row(const float* __restrict__ xrow, const float* __restrict__ gain, bf16* orow, float* of32, const LAS f32x4* wfl, float* fl, int lane) {
    const f32x4* xr = (const f32x4*)xrow + lane; const f32x4* gr = (const f32x4*)gain + lane;
    f32x4 v[8]; float s = 0.f;
#pragma unroll
    for (int j = 0; j < 8; ++j) { v[j] = xr[64 * j]; s += (v[j].x * v[j].x + v[j].y * v[j].y) + (v[j].z * v[j].z + v[j].w * v[j].w); }
    const float r = rsqrtf(wave_sum(s) * (1.f / DM) + EPS);
#pragma unroll
    for (int j = 0; j < 8; ++j) v[j] = v[j] * r * gr[64 * j];
    if (of32) {
#pragma unroll
        for (int j = 0; j < 8; ++j) ((f32x4*)of32 + lane)[64 * j] = v[j];
    } else {
        u32x2* o8 = (u32x2*)orow + lane;
#pragma unroll
        for (int j = 0; j < 8; ++j) { u32x2 w; w.x = pk2(v[j].x, v[j].y); w.y = pk2(v[j].z, v[j].w); o8[64 * j] = w; }
    }
    if (fl) {
        f32x4 p0 = (f32x4){0.f, 0.f, 0.f, 0.f}, p1 = (f32x4){0.f, 0.f, 0.f, 0.f};
#pragma unroll
        for (int j = 0; j < 8; ++j)
#pragma unroll
            for (int e = 0; e < 4; ++e) { const f32x4 w0 = wfl[((j * 4 + e) * 2 + 0) * 64 + lane], w1 = wfl[((j * 4 + e) * 2 + 1) * 64 + lane]; p0 += w0 * v[j][e]; p1 += w1 * v[j][e]; }
#pragma unroll
        for (int e = 0; e < 4; ++e) { p0[e] = wave_sum(p0[e]); p1[e] = wave_sum(p1[e]); }
        if (lane == 0) { *(f32x4*)fl = p0; *(f32x4*)(fl + 4) = p1; }
    }
}
__device__ __forceinline__ void rms_rows(const float* X, const float* gain, bf16* O, float* OF, int nrows, int gw, int NGW, int lane, const LAS f32x4* wfl = nullptr, float* FL = nullptr) {
    for (int m = gw; m < nrows; m += NGW) rms_row(X + (size_t)m * DM, gain, O ? O + (size_t)m * DM : nullptr, OF ? OF + (size_t)m * DM : nullptr, wfl, FL ? FL + (size_t)m * 8 : nullptr, lane);
}

__device__ __forceinline__ void tr_bf16_64x64(const bf16* __restrict__ src, size_t lds_, bf16* __restrict__ dst, size_t ldd, LAS unsigned char* scr, int lane) {
#pragma unroll
    for (int i = 0; i < 8; ++i) { const int id = i * 64 + lane, r = id >> 3, ch = id & 7;
        const u32x4 v = *(const u32x4*)(src + (size_t)r * lds_ + ch * 8);
#pragma unroll
        for (int e = 0; e < 4; ++e) { const unsigned w = v[e]; const int c = ch * 8 + 2 * e;
            *(LAS unsigned short*)(scr + c * 144 + r * 2) = (unsigned short)(w & 0xffffu); *(LAS unsigned short*)(scr + (c + 1) * 144 + r * 2) = (unsigned short)(w >> 16); } }
    LDS_FENCE();
#pragma unroll
    for (int i = 0; i < 8; ++i) { const int id = i * 64 + lane, c = id >> 3, ch = id & 7;
        const u32x4 v = *(const LAS u32x4*)(scr + c * 144 + ch * 16);
        *(u32x4*)(dst + (size_t)c * ldd + ch * 8) = v; }
    LDS_FENCE();
}
constexpr int AT_KP = 272, AT_VP = 144, AT_KB = 64 * AT_KP, AT_VB = 128 * AT_VP;
constexpr int AT_VOFF = 2 * AT_KB;
template <int MODE>
__device__ __forceinline__ void attn_unit(LAS unsigned char* lds, const bf16* __restrict__ Qp, int ldq, const bf16* __restrict__ Kp, int ldk, const bf16* __restrict__ VTp, int ldvt,
                                          bf16* __restrict__ Op, int ldo, int q0, int nkeys, const float* __restrict__ c2, float l2g, const bf16* __restrict__ gate) {
    int tid_ = threadIdx.x; asm volatile("" : "+v"(tid_));
    const int tid = tid_, w = __builtin_amdgcn_readfirstlane(tid >> 6), lane = tid & 63, g4 = lane >> 4, c16 = lane & 15;
    const int ntiles = (MODE == 2) ? (nkeys >> 6) : ((q0 + 256) >> 6);
    const int qw0 = q0 + w * 32;
    const int tmax = (MODE == 2) ? ntiles - 1 : ((qw0 + 31) >> 6);
    __syncthreads();
    bf16x8 qf[2][4];
#pragma unroll
    for (int qs = 0; qs < 2; ++qs)
#pragma unroll
        for (int dk = 0; dk < 4; ++dk) qf[qs][dk] = *(const bf16x8*)(Qp + (size_t)(qw0 + qs * 16 + c16) * ldq + dk * 32 + g4 * 8);
    f32x4 dkf[4];
    if (MODE == 1) {
#pragma unroll
        for (int kb = 0; kb < 4; ++kb)
#pragma unroll
            for (int j = 0; j < 4; ++j) dkf[kb][j] = __builtin_amdgcn_exp2f(-l2g * (float)(kb * 16 + g4 * 4 + j));
    }
    const int kr0 = tid >> 4, kc = tid & 15;
    const int vr0 = tid >> 3, vc = tid & 7;
    const int vq0 = (vc & 3) * 2, vq1 = vq0 + 1;
    const int vplo = (vc >> 2) * 64 + ((vq0 & 3) * 2 + (vq0 >> 2)) * 8, vphd = ((vq1 & 3) * 2 + (vq1 >> 2)) * 8 - ((vq0 & 3) * 2 + (vq0 >> 2)) * 8;
    u32x4 kreg[2], vreg[2];
#define AT_LOAD(t) do { \
        kreg[0] = *(const u32x4*)(Kp + (size_t)((t) * 64 + kr0) * ldk + kc * 8); kreg[1] = *(const u32x4*)(Kp + (size_t)((t) * 64 + kr0 + 32) * ldk + kc * 8); \
        vreg[0] = *(const u32x4*)(VTp + (size_t)vr0 * ldvt + (t) * 64 + vc * 8); vreg[1] = *(const u32x4*)(VTp + (size_t)(vr0 + 64) * ldvt + (t) * 64 + vc * 8); } while (0)
#define AT_STORE(b) do { \
        *(LAS u32x4*)(lds + (b) * AT_KB + kr0 * AT_KP + kc * 16) = kreg[0]; *(LAS u32x4*)(lds + (b) * AT_KB + (kr0 + 32) * AT_KP + kc * 16) = kreg[1]; \
        { LAS unsigned char* v_ = lds + AT_VOFF + (b) * AT_VB + vr0 * AT_VP + vplo; \
          *(LAS u32x2*)v_ = (u32x2){vreg[0].x, vreg[0].y}; *(LAS u32x2*)(v_ + vphd) = (u32x2){vreg[0].z, vreg[0].w}; \
          *(LAS u32x2*)(v_ + 64 * AT_VP) = (u32x2){vreg[1].x, vreg[1].y}; *(LAS u32x2*)(v_ + 64 * AT_VP + vphd) = (u32x2){vreg[1].z, vreg[1].w}; } } while (0)
    f32x4 O[8][2];
#pragma unroll
    for (int db = 0; db < 8; ++db) { O[db][0] = (f32x4){0.f, 0.f, 0.f, 0.f}; O[db][1] = (f32x4){0.f, 0.f, 0.f, 0.f}; }
    float mrun[2] = {-INFINITY, -INFINITY}, lsum[2] = {0.f, 0.f};
    AT_LOAD(0); AT_STORE(0);
    __syncthreads();
    for (int t = 0; t < ntiles; ++t) {
        const int cur = t & 1;
        if (t + 1 < ntiles) AT_LOAD(t + 1);
        if (t <= tmax) {
            const LAS unsigned char* Ks = lds + cur * AT_KB; const LAS unsigned char* Vs = lds + AT_VOFF + cur * AT_VB;
            f32x4 S[4][2];
#pragma unroll
            for (int kb = 0; kb < 4; ++kb) { S[kb][0] = (f32x4){0.f, 0.f, 0.f, 0.f}; S[kb][1] = (f32x4){0.f, 0.f, 0.f, 0.f};
#pragma unroll
                for (int dk = 0; dk < 4; ++dk) { const bf16x8 kf = *(const LAS bf16x8*)(Ks + (kb * 16 + c16) * AT_KP + dk * 64 + g4 * 16);
                    S[kb][0] = __builtin_amdgcn_mfma_f32_16x16x32_bf16(kf, qf[0][dk], S[kb][0], 0, 0, 0);
                    S[kb][1] = __builtin_amdgcn_mfma_f32_16x16x32_bf16(kf, qf[1][dk], S[kb][1], 0, 0, 0); } }
            const int kbase = t * 64 + g4 * 4;
            const bool diag = (MODE != 2) && (t * 64 + 63 > qw0);
            if (MODE == 1) {
#pragma unroll
                for (int qs = 0; qs < 2; ++qs) { const int qpos = qw0 + qs * 16 + c16;
                    const float dq = __builtin_amdgcn_exp2f(l2g * (float)(qpos - t * 64));
#pragma unroll
                    for (int kb = 0; kb < 4; ++kb)
#pragma unroll
                        for (int j = 0; j < 4; ++j) { float p = (S[kb][qs][j] * dq) * dkf[kb][j];
                            if (diag && (kbase + kb * 16 + j > qpos)) p = 0.f;
                            S[kb][qs][j] = p; } }
            } else {
                f32x4 ck[4];
                if (MODE == 0) {
#pragma unroll
                    for (int kb = 0; kb < 4; ++kb) ck[kb] = *(const f32x4*)(c2 + kbase + kb * 16);
                }
#pragma unroll
                for (int qs = 0; qs < 2; ++qs) { const int qpos = qw0 + qs * 16 + c16; float mx = -INFINITY;
#pragma unroll
                    for (int kb = 0; kb < 4; ++kb)
#pragma unroll
                        for (int j = 0; j < 4; ++j) { float s = S[kb][qs][j] * (QK_SCALE * LOG2E);
                            if (MODE == 0) { s -= ck[kb][j]; if (diag && (kbase + kb * 16 + j > qpos)) s = -INFINITY; }
                            S[kb][qs][j] = s; mx = fmaxf(mx, s); }
                    mx = fmaxf(mx, __shfl_xor(mx, 16)); mx = fmaxf(mx, __shfl_xor(mx, 32));
                    const float mnew = fmaxf(mrun[qs], mx);
                    const float alpha = __builtin_amdgcn_exp2f(mrun[qs] - mnew);
                    mrun[qs] = mnew; float ps = 0.f;
#pragma unroll
                    for (int kb = 0; kb < 4; ++kb)
#pragma unroll
                        for (int j = 0; j < 4; ++j) { const float p = __builtin_amdgcn_exp2f(S[kb][qs][j] - mnew); S[kb][qs][j] = p; ps += p; }
                    lsum[qs] = lsum[qs] * alpha + ps;
#pragma unroll
                    for (int db = 0; db < 8; ++db) O[db][qs] = O[db][qs] * alpha; }
            }
#pragma unroll
            for (int k2 = 0; k2 < 2; ++k2) {
                bf16x8 pb[2];
#pragma unroll
                for (int qs = 0; qs < 2; ++qs) { u32x4 pw; pw.x = pk2(S[2 * k2][qs][0], S[2 * k2][qs][1]); pw.y = pk2(S[2 * k2][qs][2], S[2 * k2][qs][3]);
                    pw.z = pk2(S[2 * k2 + 1][qs][0], S[2 * k2 + 1][qs][1]); pw.w = pk2(S[2 * k2 + 1][qs][2], S[2 * k2 + 1][qs][3]); pb[qs] = __builtin_bit_cast(bf16x8, pw); }
#pragma unroll
                for (int db = 0; db < 8; ++db) { const bf16x8 vf = *(const LAS bf16x8*)(Vs + (db * 16 + c16) * AT_VP + k2 * 64 + g4 * 16);
                    O[db][0] = __builtin_amdgcn_mfma_f32_16x16x32_bf16(vf, pb[0], O[db][0], 0, 0, 0);
                    O[db][1] = __builtin_amdgcn_mfma_f32_16x16x32_bf16(vf, pb[1], O[db][1], 0, 0, 0); }
            }
        }
        if (t + 1 < ntiles) AT_STORE(cur ^ 1);
        __syncthreads();
    }
#undef AT_LOAD
#undef AT_STORE
#pragma unroll
    for (int qs = 0; qs < 2; ++qs) {
        if (MODE == 1) {
            float s = 0.f;
#pragma unroll
            for (int db = 0; db < 8; ++db) s += (O[db][qs][0] + O[db][qs][1]) + (O[db][qs][2] + O[db][qs][3]);
            s += __shfl_xor(s, 16); s += __shfl_xor(s, 32);
            const float mu = s * (1.f / 128.f); float q = 0.f;
#pragma unroll
            for (int db = 0; db < 8; ++db) { O[db][qs] = O[db][qs] - mu; q += (O[db][qs][0] * O[db][qs][0] + O[db][qs][1] * O[db][qs][1]) + (O[db][qs][2] * O[db][qs][2] + O[db][qs][3] * O[db][qs][3]); }
            q += __shfl_xor(q, 16); q += __shfl_xor(q, 32);
            const float rs = rsqrtf(q * (1.f / 128.f) + EPS);
#pragma unroll
            for (int db = 0; db < 8; ++db) O[db][qs] = O[db][qs] * rs;
        } else {
            float l = lsum[qs]; l += __shfl_xor(l, 16); l += __shfl_xor(l, 32);
            const float inv = 1.f / l;
#pragma unroll
            for (int db = 0; db < 8; ++db) O[db][qs] = O[db][qs] * inv;
        }
    }
    LAS unsigned char* Os = lds + w * (32 * AT_KP);
#pragma unroll
    for (int qs = 0; qs < 2; ++qs)
#pragma unroll
        for (int db = 0; db < 8; ++db) { u32x2 wv; wv.x = pk2(O[db][qs][0], O[db][qs][1]); wv.y = pk2(O[db][qs][2], O[db][qs][3]);
            *(LAS u32x2*)(Os + (qs * 16 + c16) * AT_KP + (db * 16 + g4 * 4) * 2) = wv; }
    LDS_FENCE();
#pragma unroll
    for (int i = 0; i < 8; ++i) { const int id = i * 64 + lane, r = id >> 4, ch = id & 15;
        u32x4 v = *(const LAS u32x4*)(Os + r * AT_KP + ch * 16);
        if (MODE == 1) { const u32x4 gv = *(const u32x4*)(gate + (size_t)(qw0 + r) * ldq + ch * 8);
#pragma unroll
            for (int e = 0; e < 4; ++e) { const float g0 = bflo(gv[e]), g1 = bfhi(gv[e]);
                const float o0 = bflo(v[e]) * (g0 / (1.f + __expf(-g0))), o1 = bfhi(v[e]) * (g1 / (1.f + __expf(-g1))); v[e] = pk2(o0, o1); } }
        *(u32x4*)(Op + (size_t)(qw0 + r) * ldo + ch * 8) = v; }
}
constexpr int S5_BUP = 80;
constexpr int S5_WAVE = 128 * S5_BUP + 16 * 272;
constexpr int S5_XCH = 8 * S5_WAVE;
struct S5P { const float *a_re, *a_im, *b_re, *b_im, *c_re, *c_im, *dsk, *lstep; };
__device__ __forceinline__ void s5_abar(const S5P& P, int g, int p, float& ar, float& ai, float& cr, float& ci) {
    const float lr = fminf(P.a_re[g * 64 + p], -1e-4f), li = P.a_im[g * 64 + p], st = __expf(P.lstep[g * 64 + p]);
    const float zr = lr * st, zi = li * st, mag = __expf(zr);
    const float rev = zi * 0.15915494309189535f; const float fr = rev - floorf(rev);
    ar = mag * __builtin_amdgcn_cosf(fr); ai = mag * __builtin_amdgcn_sinf(fr);
    const float nr = ar - 1.f, ni = ai, den = 1.f / (lr * lr + li * li);
    cr = (nr * lr + ni * li) * den; ci = (ni * lr - nr * li) * den;
}
__device__ __forceinline__ float gelu_tanh(float y) {
    const float u = 0.7978845608028654f * (y + 0.044715f * y * y * y);
    const float t = __builtin_amdgcn_exp2f(u * (2.f * LOG2E));
    const float th = 1.f - 2.f / (t + 1.f);
    return 0.5f * y * (1.f + th);
}
__device__ __forceinline__ void s5_unit(LAS unsigned char* lds, int b, int g, const bf16* __restrict__ PROJ, bf16* __restrict__ GB, const S5P& P) {
    int tid_ = threadIdx.x; asm volatile("" : "+v"(tid_));
    const int tid = tid_, w = __builtin_amdgcn_readfirstlane(tid >> 6), lane = tid & 63, g4 = lane >> 4, c16 = lane & 15;
    LAS unsigned char* Bs = lds + w * S5_WAVE; LAS unsigned char* Xs = Bs + 128 * S5_BUP; LAS float* xch = (LAS float*)(lds + S5_XCH);
    __syncthreads();
    float ar, ai, tcr, tci; s5_abar(P, g, lane, ar, ai, tcr, tci);
    bf16x8 Bb[8];
#pragma unroll
    for (int q = 0; q < 4; ++q) { const int pp = q * 16 + c16; float a0, a1, cr, ci; s5_abar(P, g, pp, a0, a1, cr, ci);
        unsigned wr_[4], wi_[4];
#pragma unroll
        for (int e = 0; e < 4; ++e) { float re[2], im[2];
#pragma unroll
            for (int h = 0; h < 2; ++h) { const int c = (g4 & 1) * 8 + 2 * e + h; const float br = P.b_re[((size_t)g * 64 + pp) * 16 + c], bi = P.b_im[((size_t)g * 64 + pp) * 16 + c];
                re[h] = cr * br - ci * bi; im[h] = cr * bi + ci * br; }
            wr_[e] = (g4 < 2) ? pk2(re[0], re[1]) : 0u; wi_[e] = (g4 < 2) ? pk2(im[0], im[1]) : 0u; }
        u32x4 a; a.x = wr_[0]; a.y = wr_[1]; a.z = wr_[2]; a.w = wr_[3]; Bb[q] = __builtin_bit_cast(bf16x8, a);
        u32x4 c; c.x = wi_[0]; c.y = wi_[1]; c.z = wi_[2]; c.w = wi_[3]; Bb[4 + q] = __builtin_bit_cast(bf16x8, c); }
    bf16x8 Cb[4];
#pragma unroll
    for (int kb = 0; kb < 4; ++kb) { unsigned wv[4];
#pragma unroll
        for (int e = 0; e < 4; ++e) { const int pidx = kb * 16 + g4 * 4 + e; const size_t ix = ((size_t)g * 16 + c16) * 64 + pidx; wv[e] = pk2(P.c_re[ix], -P.c_im[ix]); }
        u32x4 a; a.x = wv[0]; a.y = wv[1]; a.z = wv[2]; a.w = wv[3]; Cb[kb] = __builtin_bit_cast(bf16x8, a); }
    const float dsk = P.dsk[g * 16 + c16];
    const bf16* urow = PROJ + (size_t)(b * SEQ) * ODD_IN + g * 16;
    float xr = 0.f, xi = 0.f;
    for (int pass = 0; pass < 2; ++pass) {
        u32x4 uw = (u32x4){0u, 0u, 0u, 0u}; unsigned short us[4] = {0, 0, 0, 0};
        { const int tok0 = w * 512;
          if (g4 < 2) uw = *(const u32x4*)(urow + (size_t)(tok0 + c16) * ODD_IN + g4 * 8);
          if (pass == 1) {
#pragma unroll
              for (int j = 0; j < 4; ++j) us[j] = urow[(size_t)(tok0 + g4 * 4 + j) * ODD_IN + c16]; } }
        for (int blk = 0; blk < 32; ++blk) {
            const int tok0 = w * 512 + blk * 16;
            u32x4 uwn = (u32x4){0u, 0u, 0u, 0u}; unsigned short usn[4] = {0, 0, 0, 0};
            if (blk + 1 < 32) { const int tok1 = tok0 + 16;
                if (g4 < 2) uwn = *(const u32x4*)(urow + (size_t)(tok1 + c16) * ODD_IN + g4 * 8);
                if (pass == 1) {
#pragma unroll
                    for (int j = 0; j < 4; ++j) usn[j] = urow[(size_t)(tok1 + g4 * 4 + j) * ODD_IN + c16]; } }
            const bf16x8 ua = __builtin_bit_cast(bf16x8, uw);
#pragma unroll
            for (int nb = 0; nb < 8; ++nb) { f32x4 acc = (f32x4){0.f, 0.f, 0.f, 0.f};
                acc = __builtin_amdgcn_mfma_f32_16x16x32_bf16(ua, Bb[nb], acc, 0, 0, 0);
                *(LAS f32x4*)(Bs + (nb * 16 + c16) * S5_BUP + g4 * 16) = acc; }
            __syncthreads();
#pragma unroll
            for (int k = 0; k < 4; ++k) { const f32x4 br = *(const LAS f32x4*)(Bs + lane * S5_BUP + k * 16), bi = *(const LAS f32x4*)(Bs + (64 + lane) * S5_BUP + k * 16);
#pragma unroll
                for (int j = 0; j < 4; ++j) { const float nr = ar * xr - ai * xi + br[j], ni = ar * xi + ai * xr + bi[j]; xr = nr; xi = ni;
                    if (pass == 1) *(LAS unsigned*)(Xs + (k * 4 + j) * 272 + lane * 4) = pk2(xr, xi); } }
            if (pass == 1) {
                __syncthreads();
                f32x4 y = (f32x4){0.f, 0.f, 0.f, 0.f};
#pragma unroll
                for (int kb = 0; kb < 4; ++kb) { const bf16x8 xa = *(const LAS bf16x8*)(Xs + c16 * 272 + kb * 64 + g4 * 16); y = __builtin_amdgcn_mfma_f32_16x16x32_bf16(xa, Cb[kb], y, 0, 0, 0); }
#pragma unroll
                for (int j = 0; j < 4; ++j) { const int tok = tok0 + g4 * 4 + j; const float u = __uint_as_float((unsigned)us[j] << 16);
                    const float v = gelu_tanh(y[j] + dsk * u);
                    GB[(size_t)(b * SEQ + tok) * 1024 + g * 16 + c16] = (bf16)f2bf(v); }
            }
            __syncthreads();
            uw = uwn;
#pragma unroll
            for (int j = 0; j < 4; ++j) us[j] = usn[j];
        }
        if (pass == 0) {
            xch[(w * 64 + lane) * 2] = xr; xch[(w * 64 + lane) * 2 + 1] = xi;
            __syncthreads();
            float pr = ar, pi = ai;
#pragma unroll
            for (int s = 0; s < 9; ++s) { const float nr = pr * pr - pi * pi, ni = 2.f * pr * pi; pr = nr; pi = ni; }
            xr = 0.f; xi = 0.f;
            for (int j = 0; j < w; ++j) { const float er = xch[(j * 64 + lane) * 2], ei = xch[(j * 64 + lane) * 2 + 1];
                const float nr = pr * xr - pi * xi + er, ni = pr * xi + pi * xr + ei; xr = nr; xi = ni; }
        }
    }
}
#define x_in IN(0)
#define H ((float*)(ws + WS_H))
#define XN ((bf16*)(ws + WS_XN))
#define PROJ ((bf16*)(ws + WS_PROJ))
#define MIX ((bf16*)(ws + WS_MIX))
#define VT ((bf16*)(ws + WS_VT))
#define GB ((bf16*)(ws + WS_VT))
#define QX ((bf16*)(ws + WS_QX))
#define XO ((bf16*)(ws + WS_XO))
#define FLOG ((float*)(ws + WS_FLOG))
#define C2 ((float*)(ws + WS_C2))
#define MEMN ((bf16*)(ws + WS_MEMN))
#define KVX ((bf16*)(ws + WS_KVX))
#define VTX ((bf16*)(ws + WS_VTX))
#define ROPE ((float*)(ws + WS_ROPE))
#define WKVT ((bf16*)(ws + WS_WKVT))
#define WINT ((bf16*)(ws + WS_WINT))
#define WOUTT ((bf16*)(ws + WS_WOUTT))
#define WQT ((bf16*)(ws + WS_WQT))
#define WOT ((bf16*)(ws + WS_WOT))
#define W1T ((bf16*)(ws + WS_W1T))
#define W2T ((bf16*)(ws + WS_W2T))
#define WGLUT ((bf16*)(ws + WS_WGLUT))
#define SSQ ((float*)(ws + WS_SSQ))
#define IN(i) ((const float*)(const __attribute__((address_space(1))) float*)(unsigned long long)(args.in[(i) + zz]))
#define run_gemm(lds, ...) run_gemm_(lds, G, bid, __VA_ARGS__)
constexpr int PH_PER_LAYER = 10, N_PHASES = DEPTH * PH_PER_LAYER + 1;
using GOrder = pg8::StaticOrder;
template <class Epi> __device__ __forceinline__ void run_gemm_(LAS unsigned char* lds, int G, int bid, const bf16* A, const bf16* Bt, int M, int N, int K, const Epi& E) {
    pg8::Gemm g{A, Bt, M, N, K}; GOrder S; S.init(M, N, G, bid);
#ifndef NO_GEMM
    pg8::gemm_phase<Epi, GOrder, true, true>(lds, g, S, E);
#endif
}

#define RLX_AGENT __ATOMIC_RELAXED, __HIP_MEMORY_SCOPE_AGENT
#define XB_TMO      128
#define XB_XCNT(j)  (256  + 64 * (j))
#define XB_XSUB(j)  (1280 + 64 * (j))
#define XB_XGEN(j)  (2304 + 64 * (j))
#define XB_TOP      3328
#define XB_TOPGEN   3392
#define XCD_BAR_WORDS 3456
#define XB_SPIN_CAP (1u << 23)

__device__ __forceinline__ unsigned xb_ld(unsigned* p)              { return __hip_atomic_load(p, __ATOMIC_RELAXED, __HIP_MEMORY_SCOPE_AGENT); }
__device__ __forceinline__ unsigned xb_add(unsigned* p, unsigned v) { return __hip_atomic_fetch_add(p, v, __ATOMIC_RELAXED, __HIP_MEMORY_SCOPE_AGENT); }
__device__ __forceinline__ unsigned xb_xcc_id() { return (unsigned)__builtin_amdgcn_s_getreg((3 << 11) | 20) & 0xFu; }
#define XB_SPIN(cond, bar) do { unsigned _sp = 0; while (cond) { __builtin_amdgcn_s_sleep(1); \
    if ((++_sp & 255u) == 0u) { if (xb_ld(&(bar)[XB_TMO])) break; if (_sp > XB_SPIN_CAP) { atomicAdd(&(bar)[XB_TMO], 1u); break; } } } } while (0)

struct XcdBarrier {
    unsigned* bar; unsigned x;
    volatile LAS unsigned* st;
};

__device__ __forceinline__ XcdBarrier xcd_barrier_post(unsigned* bar, volatile LAS unsigned* st) {
    XcdBarrier b; b.bar = bar; b.x = xb_xcc_id(); b.st = st;
    if (threadIdx.x == 0) (void)xb_add(&bar[XB_XCNT(b.x)], 1u);
    return b;
}
__device__ __forceinline__ void xcd_barrier_complete(unsigned* bar, unsigned x, unsigned& nloc, unsigned& nx) {
    const unsigned G = gridDim.x * gridDim.y * gridDim.z;
    unsigned sum, cnt, mine, sp = 0u;
    for (;;) {
        sum = 0u; cnt = 0u; mine = 0u;
#pragma unroll
        for (unsigned j = 0; j < 16; ++j) { const unsigned c = xb_ld(&bar[XB_XCNT(j)]); sum += c; cnt += (c > 0u) ? 1u : 0u; mine = (j == x) ? c : mine; }
        if (sum == G) break;
        __builtin_amdgcn_s_sleep(1);
        if ((++sp & 255u) == 0u) { if (xb_ld(&bar[XB_TMO])) break; if (sp > XB_SPIN_CAP) { atomicAdd(&bar[XB_TMO], 1u); break; } }
    }
    nloc = mine > 0u ? mine : 1u; nx = cnt > 0u ? cnt : 1u;
}

__device__ __forceinline__ void xcd_barrier(const XcdBarrier& b) {
    asm volatile("s_waitcnt vmcnt(0)" ::: "memory");
    __syncthreads();
    if (threadIdx.x == 0) {
        unsigned* bar = b.bar;
        __builtin_amdgcn_s_waitcnt(0);
        unsigned nloc = b.st[0], nx = b.st[1];
        if (nloc == 0u) { xcd_barrier_complete(bar, b.x, nloc, nx); b.st[0] = nloc; b.st[1] = nx; }
        const unsigned old = xb_add(&bar[XB_XSUB(b.x)], 1u);
        const unsigned gen = old / nloc;
        if (old + 1u == (gen + 1u) * nloc) {
            __builtin_amdgcn_fence(__ATOMIC_RELEASE, "agent");
            asm volatile("s_waitcnt vmcnt(0)" ::: "memory");
            const unsigned og = xb_add(&bar[XB_TOP], 1u);
            const unsigned tg = og / nx;
            if (og + 1u == (tg + 1u) * nx) xb_add(&bar[XB_TOPGEN], 1u);
            else XB_SPIN(xb_ld(&bar[XB_TOPGEN]) == tg, bar);
            __builtin_amdgcn_fence(__ATOMIC_ACQUIRE, "agent");
            xb_add(&bar[XB_XGEN(b.x)], 1u);
            asm volatile("s_waitcnt vmcnt(0)" ::: "memory");
        } else {
            XB_SPIN(xb_ld(&bar[XB_XGEN(b.x)]) == gen, bar);
            __builtin_amdgcn_fence(__ATOMIC_ACQUIRE, "agent");
            asm volatile("s_waitcnt vmcnt(0)" ::: "memory");
        }
    }
    __syncthreads();
}

__device__ __forceinline__ void grid_bar(unsigned* cnt, unsigned target) {
#ifdef DBG_DELAY
    { const unsigned long long t0 = __builtin_amdgcn_s_memrealtime(); while (__builtin_amdgcn_s_memrealtime() - t0 < (unsigned long long)DBG_DELAY) __builtin_amdgcn_s_sleep(8); }
#endif
    asm volatile("s_waitcnt vmcnt(0) lgkmcnt(0)" ::: "memory");
    __syncthreads();
    if (threadIdx.x == 0) {
        __builtin_amdgcn_fence(__ATOMIC_RELEASE, "");
        asm volatile("s_waitcnt vmcnt(0)" ::: "memory");
        __hip_atomic_fetch_add(cnt, 1u, __ATOMIC_RELAXED, __HIP_MEMORY_SCOPE_AGENT);
        while (__hip_atomic_load(cnt, __ATOMIC_RELAXED, __HIP_MEMORY_SCOPE_AGENT) < target) __builtin_amdgcn_s_sleep(1);
        __builtin_amdgcn_fence(__ATOMIC_ACQUIRE, "");
        asm volatile("s_waitcnt vmcnt(0)" ::: "memory");
    }
    __syncthreads();
}
__global__ void __launch_bounds__(512, 2) trunk_fwd(Args args) {
    extern __shared__ __attribute__((aligned(16))) unsigned char lds_raw[];
    LAS unsigned char* lds = (LAS unsigned char*)lds_raw;
    cg::grid_group grid = cg::this_grid();
    const int lo = args.ph_lo, hi = args.ph_hi;
    int ph = 0; unsigned nbar = 0; (void)nbar;
    if (threadIdx.x < 2) ((volatile LAS unsigned*)(lds + LDS_BYTES - 64))[threadIdx.x] = 0u;
    __syncthreads();
    XcdBarrier xbar = xcd_barrier_post((unsigned*)args.ws, (volatile LAS unsigned*)(lds + LDS_BYTES - 64));
#ifdef DBG_LDSFILL
    for (int i = threadIdx.x; i < LDS_BYTES / 16; i += 512) ((LAS u32x4*)lds)[i] = (u32x4){0u, 0u, 0u, 0u};
    __syncthreads();
#endif
#ifdef DBG_FILL
    { u32x4* p = (u32x4*)(args.ws + MiB); const size_t n = (WS_END - MiB) / 16; for (size_t i = (size_t)blockIdx.x * 512 + threadIdx.x; i < n; i += (size_t)gridDim.x * 512) p[i] = (u32x4){0u, 0u, 0u, 0u}; }
#endif
    if (hi - lo > 1) grid.sync();
#ifndef DBG_NPH
#define DBG_NPH 1000
#endif
#define PH_BEGIN if (ph >= lo && ph < hi && (ph < DBG_NPH || ph == N_PHASES - 1)) { __attribute__((address_space(1))) unsigned char* ws = (__attribute__((address_space(1))) unsigned char*)(unsigned long long)args.ws; int zz = 0; int tid = threadIdx.x; int G = gridDim.x; int bid = blockIdx.x; asm volatile("" : "+s"(ws), "+s"(zz), "+v"(tid), "+s"(G), "+s"(bid)); const int lane = tid & 63, wave = __builtin_amdgcn_readfirstlane(tid >> 6), gw = bid * 8 + wave, NGW = G * 8; (void)lane; (void)gw; (void)NGW;
#ifdef DBG_DUP_BAR
#define PH_END } if (ph >= lo && ph + 1 < hi) { ++nbar; grid_bar((unsigned*)args.ws, nbar * gridDim.x); ++nbar; grid_bar((unsigned*)args.ws, nbar * gridDim.x); } ++ph;
#else
#define PH_END } if (ph >= lo && ph + 1 < hi) { xcd_barrier(xbar); } ++ph;
#endif

#ifdef DBG_COPYX
    { const float* xs = args.in[0]; for (size_t i = (size_t)blockIdx.x * 512 + threadIdx.x; i < (size_t)NT * DM; i += (size_t)gridDim.x * 512) args.out[i] = xs[i]; return; }
#endif
#ifdef DBG_BARTEST
    { float* flag = (float*)(args.ws + 512 * 1024);
      if (blockIdx.x == 5) { const unsigned long long t0 = __builtin_amdgcn_s_memrealtime(); while (__builtin_amdgcn_s_memrealtime() - t0 < 300000ull) __builtin_amdgcn_s_sleep(8);
          if (threadIdx.x == 0) flag[0] = 1234.5f; }
#if DBG_BARTEST == 1
      ++nbar; grid_bar((unsigned*)args.ws, nbar * gridDim.x);
#else
      grid.sync();
#endif
      const float f = __hip_atomic_load(flag, __ATOMIC_RELAXED, __HIP_MEMORY_SCOPE_AGENT);
      for (size_t i = (size_t)blockIdx.x * 512 + threadIdx.x; i < (size_t)NT * DM; i += (size_t)gridDim.x * 512) args.out[i] = f;
      return; }
#endif
#pragma unroll 1
    for (int layer = 0; layer < DEPTH; ++layer) {
        const bool even = (layer & 1) == 0;
#ifdef DBG_SUB0
        const int sub = 0;
#else
        const int sub = layer >> 1;
#endif
        PH_BEGIN
            LAS float* scr = (LAS float*)(lds + wave * 16384); int tbase = 0;
#ifdef DBG_DUP_A
            for (int rep = 0; rep < 2; ++rep) {
#endif
            if (layer == 0) {
                rms_rows(IN(1), IN(5), MEMN, nullptr, NB * MEML, gw, NGW, lane);
                for (int l = 0; l < DEPTH; ++l) tr_matrix(IN(23) + (size_t)l * DM * 1024, 1024, DM, 0, 1024, WKVT, l * 1024, scr, gw, NGW, lane, tbase);
                for (int idx = bid * 512 + tid; idx < SEQ * 64; idx += G * 512) { const int pos = idx >> 6, i = idx & 63;
                    const float inv = powf(10000.f, -(float)i * (1.f / 64.f)); const float ang = (float)pos * inv;
                    const double rev = (double)ang * 0.15915494309189535; const float fr = (float)(rev - floor(rev));
                    ROPE[idx] = __builtin_amdgcn_cosf(fr); ROPE[SEQ * 64 + idx] = __builtin_amdgcn_sinf(fr); }
            }
            if (even) {
                const float* Win = IN(7) + (size_t)sub * DM * EVEN_IN;
                tr_matrix(Win, EVEN_IN, DM, 0, 3072, WINT, 0, scr, gw, NGW, lane, tbase);
                tr_matrix(Win, EVEN_IN, DM, 3080, 4096, WINT, 3072, scr, gw, NGW, lane, tbase);
                tr_matrix(IN(9) + (size_t)sub * DM * DM, DM, DM, 0, DM, WOUTT, 0, scr, gw, NGW, lane, tbase);
            } else {
                tr_matrix(IN(10) + (size_t)sub * DM * ODD_IN, ODD_IN, DM, 0, ODD_IN, WINT, 0, scr, gw, NGW, lane, tbase, IN(2) + layer * DM);
                tr_matrix(IN(19) + (size_t)sub * 1024 * 1024, 1024, 1024, 0, 1024, WGLUT, 0, scr, gw, NGW, lane, tbase);
                tr_matrix(IN(21) + (size_t)sub * DM * DM, DM, DM, 0, DM, WOUTT, 0, scr, gw, NGW, lane, tbase);
            }
            tr_matrix(IN(22) + (size_t)layer * DM * XAW, XAW, DM, 0, XAW, WQT, 0, scr, gw, NGW, lane, tbase, IN(3) + layer * DM);
            tr_matrix(IN(24) + (size_t)layer * XAW * DM, DM, XAW, 0, DM, WOT, 0, scr, gw, NGW, lane, tbase);
            tr_matrix(IN(25) + (size_t)layer * DM * DFF, DFF, DM, 0, DFF, W1T, 0, scr, gw, NGW, lane, tbase, IN(4) + layer * DM);
            tr_matrix(IN(26) + (size_t)layer * DFF * DM, DM, DFF, 0, DM, W2T, 0, scr, gw, NGW, lane, tbase);
            if (even) {
                __syncthreads();
                const float* wf = IN(7) + (size_t)sub * DM * EVEN_IN + 3072; LAS f32x4* wfl = (LAS f32x4*)lds;
                for (int i = tid; i < 4096; i += 512) { const int k = i >> 1, half = i & 1; wfl[((((k >> 8) * 4 + (k & 3)) * 2 + half) * 64) + ((k >> 2) & 63)] = *(const f32x4*)(wf + (size_t)k * EVEN_IN + half * 4); }
                __syncthreads();
                rms_rows((layer == 0) ? x_in : H, IN(2) + layer * DM, XN, nullptr, NT, gw, NGW, lane, wfl, FLOG);
            }
#ifdef DBG_DUP_A
            }
#endif
        PH_END
        PH_BEGIN
            if (even) { pg8::EpiBf E{PROJ, EVEN_LD, 0, nullptr, -1, nullptr}; run_gemm(lds, XN, WINT, NT, EVEN_N, DM, E); }
#ifdef DBG_TWICE
            if (layer == 2) { pg8::EpiBf E2{MIX, DM, 0, nullptr, -1, nullptr}; run_gemm(lds, XN, WINT, NT, DM, DM, E2); }
#endif
            else { pg8::EpiBf E{PROJ, ODD_IN, 0, nullptr, -1, SSQ}; run_gemm(lds, XN, WINT, NT, ODD_IN, DM, E); }
            if (layer == 0) { pg8::EpiBf E{KVX, 4096, 0, nullptr, -1, nullptr}; run_gemm(lds, MEMN, WKVT, NB * MEML, 4096, DM, E); }
        PH_END
        if (even) {
            PH_BEGIN
                if (bid < 32) {
                    const int b = bid >> 3, h = bid & 7; const float bias = IN(8)[sub * 8 + h];
                    float v[8]; float run = 0.f;
#pragma unroll
                    for (int e = 0; e < 8; ++e) { const float xx = FLOG[(size_t)(b * SEQ + tid * 8 + e) * 8 + h] + bias;
                        const float ls = fminf(xx, 0.f) - log1pf(__expf(-fabsf(xx))); run += ls; v[e] = run; }
                    float inc = run;
#pragma unroll
                    for (int o = 1; o < 64; o <<= 1) { const float t = __shfl_up(inc, o); if (lane >= o) inc += t; }
                    LAS float* wsum = (LAS float*)(lds + 131072);
                    __syncthreads();
                    if (lane == 63) wsum[wave] = inc;
                    __syncthreads();
                    float off = inc - run;
                    for (int j = 0; j < wave; ++j) off += wsum[j];
#pragma unroll
                    for (int e = 0; e < 8; ++e) C2[(size_t)(b * 8 + h) * SEQ + tid * 8 + e] = (v[e] + off) * LOG2E;
                }
                for (int t = gw; t < NT; t += NGW) { const int pos = t & (SEQ - 1), slot = lane >> 2, i0 = (lane & 3) * 16;
                    bf16* p1 = PROJ + (size_t)t * EVEN_LD + 3072 + slot * 128 + i0; bf16* p2 = p1 + 64;
                    const float sc = (slot >= 8) ? QK_SCALE : 1.f;
#pragma unroll
                    for (int hlf = 0; hlf < 2; ++hlf) { const u32x4 a = *(const u32x4*)(p1 + hlf * 8), c = *(const u32x4*)(p2 + hlf * 8); u32x4 o1, o2;
#pragma unroll
                        for (int e = 0; e < 4; ++e) { const int ii = i0 + hlf * 8 + 2 * e;
                            const float c0 = ROPE[pos * 64 + ii], c1 = ROPE[pos * 64 + ii + 1], s0 = ROPE[SEQ * 64 + pos * 64 + ii], s1 = ROPE[SEQ * 64 + pos * 64 + ii + 1];
                            const float a0 = bflo(a[e]), a1 = bfhi(a[e]), b0 = bflo(c[e]), b1 = bfhi(c[e]);
                            o1[e] = pk2((a0 * c0 - b0 * s0) * sc, (a1 * c1 - b1 * s1) * sc); o2[e] = pk2((a0 * s0 + b0 * c0) * sc, (a1 * s1 + b1 * c1) * sc); }
                        *(u32x4*)(p1 + hlf * 8) = o1; *(u32x4*)(p2 + hlf * 8) = o2; } }
                { LAS unsigned char* scr = lds + wave * 9216;
                  for (int it = gw; it < NB * 16 * 64 * 2; it += NGW) { const int dh = it & 1, tb = (it >> 1) & 63, h16 = (it >> 7) & 15, b = it >> 11;
                      const bf16* src = PROJ + (size_t)(b * SEQ + tb * 64) * EVEN_LD + (h16 < 8 ? 2048 + h16 * 128 : 5120 + (h16 - 8) * 128) + dh * 64;
                      bf16* dst = VT + ((size_t)(b * 16 + h16) * 128 + dh * 64) * SEQ + tb * 64;
                      tr_bf16_64x64(src, EVEN_LD, dst, SEQ, scr, lane); }
                  if (layer == 0) for (int it = gw; it < DEPTH * NB * 4 * 4 * 2; it += NGW) { const int dh = it & 1, kb = (it >> 1) & 3, h = (it >> 3) & 3, b = (it >> 5) & 3, l = it >> 7;
                      const bf16* src = KVX + (size_t)(b * MEML + kb * 64) * 4096 + l * 1024 + 512 + h * 128 + dh * 64;
                      bf16* dst = VTX + ((size_t)((l * NB + b) * 4 + h) * 128 + dh * 64) * MEML + kb * 64;
                      tr_bf16_64x64(src, 4096, dst, MEML, scr, lane); } }
            PH_END
            PH_BEGIN
                const int NU = NB * 16 * 16;
#ifdef DBG_DUP_ATTN
                for (int rep = 0; rep < 2; ++rep)
#endif
                for (int r = 0; r * G < NU; ++r) { const int sidx = r * G + ((r & 1) ? (G - 1 - bid) : bid); if (sidx >= NU) continue;
                    const int qb = 15 - (sidx >> 6), bh = sidx & 63, b = bh >> 4, h16 = bh & 15, h = h16 & 7;
                    const bf16* rowb = PROJ + (size_t)(b * SEQ) * EVEN_LD; const bf16* vt = VT + (size_t)(b * 16 + h16) * 128 * SEQ; bf16* ob = MIX + (size_t)(b * SEQ) * DM;
#ifndef NO_ATTN
                    if (h16 < 8) attn_unit<0>(lds, rowb + h * 128, EVEN_LD, rowb + 1024 + h * 128, EVEN_LD, vt, SEQ, ob + h * 128, DM, qb * 256, 0, C2 + (size_t)(b * 8 + h) * SEQ, 0.f, nullptr);
                    else { const float l2g = log2f(1.f - exp2f(-5.f - (float)h));
                        attn_unit<1>(lds, rowb + 3072 + h * 128, EVEN_LD, rowb + 4096 + h * 128, EVEN_LD, vt, SEQ, ob + 1024 + h * 128, DM, qb * 256, 0, nullptr, l2g, rowb + 6144 + h * 128); }
#endif
                }
            PH_END
        } else {
            PH_BEGIN
#ifdef DBG_DUP_S5
                for (int rep = 0; rep < 2; ++rep) {
#endif
                S5P P{IN(11) + sub * 4096, IN(12) + sub * 4096, IN(13) + (size_t)sub * 65536, IN(14) + (size_t)sub * 65536,
                      IN(15) + (size_t)sub * 65536, IN(16) + (size_t)sub * 65536, IN(17) + sub * 1024, IN(18) + sub * 4096};
#ifndef NO_S5
                for (int u = bid; u < NB * 64; u += G) s5_unit(lds, u >> 6, u & 63, PROJ, GB, P);
#endif
                const float* cw = IN(20) + sub * 3 * 1024;
                for (int idx = bid * 512 + tid; idx < NT * 128; idx += G * 512) { const int tok = idx >> 7, ch = (idx & 127) * 8, l = tok & (SEQ - 1);
                    const bf16* row = PROJ + (size_t)tok * ODD_IN;
                    float acc[8];
#pragma unroll
                    for (int e = 0; e < 8; ++e) acc[e] = 0.f;
#pragma unroll
                    for (int k = 0; k < 3; ++k) { const int back = 2 - k; if (l - back < 0) continue;
                        const u32x4 hv = *(const u32x4*)(row - (size_t)back * ODD_IN + 1024 + ch), gc = *(const u32x4*)(row - (size_t)back * ODD_IN + 3072 + ch);
                        const f32x4 w0 = *(const f32x4*)(cw + k * 1024 + ch), w1 = *(const f32x4*)(cw + k * 1024 + ch + 4);
#pragma unroll
                        for (int e = 0; e < 4; ++e) { const float wa = (e < 2) ? w0[2 * e] : w1[2 * e - 4], wb = (e < 2) ? w0[2 * e + 1] : w1[2 * e - 3];
                            acc[2 * e] += wa * (bflo(hv[e]) * bflo(gc[e])); acc[2 * e + 1] += wb * (bfhi(hv[e]) * bfhi(gc[e])); } }
                    const u32x4 gb = *(const u32x4*)(row + 2048 + ch); u32x4 o;
#pragma unroll
                    for (int e = 0; e < 4; ++e) o[e] = pk2(bflo(gb[e]) * acc[2 * e], bfhi(gb[e]) * acc[2 * e + 1]);
                    *(u32x4*)(MIX + (size_t)tok * DM + 1024 + ch) = o; }
#ifdef DBG_DUP_S5
                }
#endif
            PH_END
            PH_BEGIN
                pg8::EpiGlu E{GB, 1024, MIX, DM}; run_gemm(lds, GB, WGLUT, NT, 1024, 1024, E);
            PH_END
        }
        PH_BEGIN
            pg8::EpiResid E{(layer == 0) ? x_in : H, H, DM, XN, SSQ}; run_gemm(lds, MIX, WOUTT, NT, DM, DM, E);
        PH_END
        PH_BEGIN
            pg8::EpiBf E{QX, XAW, 0, nullptr, -1, SSQ}; run_gemm(lds, XN, WQT, NT, XAW, DM, E);
        PH_END
        PH_BEGIN
            for (int u = bid; u < NB * 4 * 16; u += G) { const int qb = u & 15, h = (u >> 4) & 3, b = u >> 6;
#ifndef NO_XATTN
                attn_unit<2>(lds, QX + (size_t)(b * SEQ) * XAW + h * 128, XAW, KVX + (size_t)(b * MEML) * 4096 + layer * 1024 + h * 128, 4096,
                             VTX + (size_t)((layer * NB + b) * 4 + h) * 128 * MEML, MEML, XO + (size_t)(b * SEQ) * XAW + h * 128, XAW, qb * 256, MEML, nullptr, 0.f, nullptr);
#endif
            }
        PH_END
        PH_BEGIN
            pg8::EpiResid E{H, H, DM, XN, SSQ}; run_gemm(lds, XO, WOT, NT, DM, XAW, E);
        PH_END
        PH_BEGIN
#ifndef DBG_SKIPMLP
            pg8::EpiBf E{PROJ, DFF, 1, nullptr, -1, SSQ}; run_gemm(lds, XN, W1T, NT, DFF, DM, E);
#endif
        PH_END
        PH_BEGIN
#ifndef DBG_SKIPMLP
            pg8::EpiResid E{H, H, DM, even ? XN : nullptr, even ? SSQ : nullptr}; run_gemm(lds, PROJ, W2T, NT, DM, DFF, E);
#endif
        PH_END
    }
    PH_BEGIN
#ifdef DBG_OUTBUF
        { const bf16* src = (const bf16*)(ws + DBG_OUTBUF); for (size_t i = (size_t)bid * 512 + tid; i < (size_t)NT * DM; i += (size_t)G * 512) { const size_t t = i >> 11, c = i & 2047; float v = __uint_as_float((unsigned)src[t * DBG_OUTLD + DBG_OUTCOL + c] << 16);
#ifdef DBG_TWICE
            v -= __uint_as_float((unsigned)MIX[t * DM + c] << 16);
#endif
            args.out[i] = v; } }
#else
        rms_rows(H, IN(6), nullptr, args.out, NT, gw, NGW, lane);
#endif
    PH_END
#undef PH_BEGIN
#undef PH_END
}
#undef H
#undef XN
#undef PROJ
#undef MIX
#undef VT
#undef GB
#undef QX
#undef XO
#undef IN
#undef x_in

extern "C" void kernel_launch(void* const* d_in, const int* in_sizes, int n_in, void* d_out, int out_size, void* d_ws, size_t ws_size, hipStream_t stream) {
    static int grid = 0;
    if (grid == 0) {
        if (n_in != 27 || out_size != NT * DM || ws_size < WS_END) { fprintf(stderr, "kernel_launch: unexpected problem (n_in %d out %d ws %zu, need %zu)\n", n_in, out_size, ws_size, (size_t)WS_END); grid = -1; return; }
        int dev = 0, cus = 0, per_cu = 0;
        hipGetDevice(&dev); hipDeviceGetAttribute(&cus, hipDeviceAttributeMultiprocessorCount, dev);
        if (hipFuncSetAttribute((const void*)trunk_fwd, hipFuncAttributeMaxDynamicSharedMemorySize, LDS_BYTES) != hipSuccess) { fprintf(stderr, "kernel_launch: hipFuncSetAttribute failed\n"); grid = -1; return; }
        hipOccupancyMaxActiveBlocksPerMultiprocessor(&per_cu, (const void*)trunk_fwd, 512, LDS_BYTES);
        if (per_cu < 1) { fprintf(stderr, "kernel_launch: occupancy query says %d blocks/CU\n", per_cu); per_cu = 1; }
        (void)hipGetLastError();
        grid = cus * 1;
    }
    if (grid < 0) return;
    (void)hipMemsetAsync(d_ws, 0, 16384, stream);
    Args a{};
    for (int i = 0; i < 27; ++i) a.in[i] = (const float*)d_in[i];
    a.out = (float*)d_out; a.ws = (unsigned char*)d_ws;
#if MK_ONE_LAUNCH
    a.ph_lo = 0; a.ph_hi = N_PHASES;
    { void* kargs[] = {&a}; hipError_t e = hipLaunchCooperativeKernel((const void*)trunk_fwd, dim3(grid), dim3(512), kargs, LDS_BYTES, stream);
      if (e != hipSuccess) fprintf(stderr, "cooperative launch failed: %s (grid %d)\n", hipGetErrorString(e), grid); }
#else
    for (int p = 0; p < N_PHASES; ++p) { a.ph_lo = p; a.ph_hi = p + 1;
        void* kargs[] = {&a}; hipError_t e = hipLaunchCooperativeKernel((const void*)trunk_fwd, dim3(grid), dim3(512), kargs, LDS_BYTES, stream);
        if (e != hipSuccess) { fprintf(stderr, "launch %d failed: %s (grid %d)\n", p, hipGetErrorString(e), grid); break; } }
#endif
}
```
